# Optimizing an MI355X kernel written in HIP

```python
import jax
import jax.numpy as jnp
from jax import lax
import numpy as np

D_MODEL = 1024
BATCH = 1
SEQ = 16384
DEPTH = 2

HEAD_DIM = 64
ROPE_THETA = 10000.0
NORM_EPS = 1e-6
Q_BLOCK = 128
NEG_INF = -1e30
FORCE_SELECT = 1e9

NSA_HEADS = 8
NSA_KV_GROUPS = 2
NSA_HEADS_PER_GROUP = NSA_HEADS // NSA_KV_GROUPS
NSA_CMP_LEN = 32
NSA_CMP_STRIDE = 16
NSA_SEL_LEN = 64
NSA_SEL_TOPK = 16
NSA_WINDOW = 512
NSA_BRANCHES = 3

MOBA_HEADS = 8
MOBA_BLOCK = 256
MOBA_TOPK = 3

MEM_LEN = 256
MEM_HEADS = 4

RET_HEADS = 4
RET_QK_DIM = D_MODEL // RET_HEADS
RET_V_DIM = 2 * D_MODEL // RET_HEADS
RET_CHUNK = 128

NSA_Q_W = NSA_HEADS * HEAD_DIM
NSA_KV_W = NSA_KV_GROUPS * HEAD_DIM
MOBA_W = MOBA_HEADS * HEAD_DIM
MEM_W = MEM_HEADS * HEAD_DIM
RET_QK_W = RET_HEADS * RET_QK_DIM
RET_V_W = RET_HEADS * RET_V_DIM

EVEN_SPLITS = (NSA_Q_W, NSA_KV_W, NSA_KV_W, NSA_KV_W, NSA_KV_W, NSA_KV_W, NSA_KV_W,
               NSA_BRANCHES * NSA_HEADS, NSA_Q_W,
               MOBA_W, MOBA_W, MOBA_W, MOBA_W,
               MEM_W, MEM_W)
ODD_SPLITS = (RET_QK_W, RET_QK_W, RET_V_W, RET_V_W, MEM_W, MEM_W)
EVEN_IN_W = sum(EVEN_SPLITS)
EVEN_OUT_W = NSA_Q_W + MOBA_W + MEM_W
ODD_IN_W = sum(ODD_SPLITS)
ODD_OUT_W = RET_V_W + MEM_W

kernel_name = 'hybrid_nsa_moba_retention_memory'


def _split(h, sizes):
    cuts = np.cumsum(np.array(sizes))[:-1].tolist()
    return jnp.split(h, cuts, axis=-1)


def rms_norm(x, g):
    xf = x.astype(jnp.float32)
    y = xf * lax.rsqrt(jnp.mean(xf * xf, axis=-1, keepdims=True) + NORM_EPS)
    return (y * g.astype(jnp.float32)).astype(x.dtype)


def rotary_tables(positions, inv_freq):
    ang = positions.astype(jnp.float32)[..., None] * inv_freq
    return jnp.cos(ang), jnp.sin(ang)


def apply_rotary(x, cos, sin):
    x1, x2 = jnp.split(x, 2, axis=-1)
    c = cos[:, :, None, :].astype(x.dtype)
    s = sin[:, :, None, :].astype(x.dtype)
    return jnp.concatenate([x1 * c - x2 * s, x1 * s + x2 * c], axis=-1)


def masked_softmax(s, mask):
    s = jnp.where(mask, s.astype(jnp.float32), NEG_INF)
    m = jnp.max(s, axis=-1, keepdims=True)
    p = jnp.where(mask, jnp.exp(s - m), 0.0)
    return p / jnp.maximum(jnp.sum(p, axis=-1, keepdims=True), 1e-30)


def nsa_compress(a, pe, w1, w2):
    T = a.shape[1]
    n_cmp = (T - NSA_CMP_LEN) // NSA_CMP_STRIDE + 1
    idx = np.arange(n_cmp)[:, None] * NSA_CMP_STRIDE + np.arange(NSA_CMP_LEN)[None, :]
    blocks = a[:, idx] + pe[None, None, :, None, :].astype(a.dtype)
    hid = jax.nn.silu(jnp.einsum('bnlgd,lde->bnge', blocks, w1))
    return jnp.einsum('bnge,ef->bngf', hid, w2)


def nsa_attention(q, kc, vc, ks, vs, kw, vw, gates):
    Bsz, T = q.shape[0], q.shape[1]
    G, I, D = NSA_KV_GROUPS, NSA_HEADS_PER_GROUP, HEAD_DIM
    n_cmp = kc.shape[1]
    n_sel = T // NSA_SEL_LEN
    k_sel = min(NSA_SEL_TOPK, n_sel)
    scale = HEAD_DIM ** -0.5
    cmp_start = jnp.arange(n_cmp) * NSA_CMP_STRIDE
    cmp_end = cmp_start + NSA_CMP_LEN - 1
    sel_start = jnp.arange(n_sel) * NSA_SEL_LEN
    overlap = ((cmp_start[:, None] < sel_start[None, :] + NSA_SEL_LEN) &
               (cmp_start[:, None] + NSA_CMP_LEN > sel_start[None, :])).astype(jnp.float32)
    ks_blk = ks.reshape(Bsz, n_sel, NSA_SEL_LEN, G, D).transpose(0, 3, 1, 2, 4)
    vs_blk = vs.reshape(Bsz, n_sel, NSA_SEL_LEN, G, D).transpose(0, 3, 1, 2, 4)
    kw_pad = jnp.pad(kw, ((0, 0), (NSA_WINDOW, 0), (0, 0), (0, 0)))
    vw_pad = jnp.pad(vw, ((0, 0), (NSA_WINDOW, 0), (0, 0), (0, 0)))
    b_idx = jnp.arange(Bsz)[:, None, None, None]
    g_idx = jnp.arange(G)[None, :, None, None]
    sel_blocks = jnp.arange(n_sel)

    def block(bi):
        t0 = bi * Q_BLOCK
        t = t0 + jnp.arange(Q_BLOCK)
        qb = lax.dynamic_slice_in_dim(q, t0, Q_BLOCK, axis=1).reshape(Bsz, Q_BLOCK, G, I, D)
        gb = lax.dynamic_slice_in_dim(gates, t0, Q_BLOCK, axis=1).reshape(Bsz, Q_BLOCK, NSA_BRANCHES, G, I)
        s_c = jnp.einsum('bqgid,bngd->bgiqn', qb, kc) * scale
        p_c = masked_softmax(s_c, cmp_end[None, :] <= t[:, None])
        o_c = jnp.einsum('bgiqn,bngd->bqgid', p_c.astype(vc.dtype), vc)
        imp = jnp.einsum('bgiqn,ns->bgqs', p_c, overlap)
        cur = t // NSA_SEL_LEN
        forced = ((sel_blocks[None, :] == 0) | (sel_blocks[None, :] == cur[:, None]) |
                  (sel_blocks[None, :] == cur[:, None] - 1))
        imp = jnp.where(forced, FORCE_SELECT, imp)
        imp = jnp.where(sel_blocks[None, :] <= cur[:, None], imp, NEG_INF)
        _, sel = lax.top_k(imp, k_sel)
        k_g = ks_blk[b_idx, g_idx, sel]
        v_g = vs_blk[b_idx, g_idx, sel]
        kpos = sel[..., None] * NSA_SEL_LEN + jnp.arange(NSA_SEL_LEN)
        mask_s = (kpos <= t[None, None, :, None, None]).reshape(Bsz, G, 1, Q_BLOCK, k_sel * NSA_SEL_LEN)
        s_s = jnp.einsum('bqgid,bgqkld->bgiqkl', qb, k_g).reshape(Bsz, G, I, Q_BLOCK, k_sel * NSA_SEL_LEN) * scale
        p_s = masked_softmax(s_s, mask_s).reshape(Bsz, G, I, Q_BLOCK, k_sel, NSA_SEL_LEN)
        o_s = jnp.einsum('bgiqkl,bgqkld->bqgid', p_s.astype(v_g.dtype), v_g)
        kwb = lax.dynamic_slice_in_dim(kw_pad, t0, Q_BLOCK + NSA_WINDOW, axis=1)
        vwb = lax.dynamic_slice_in_dim(vw_pad, t0, Q_BLOCK + NSA_WINDOW, axis=1)
        wpos = t0 - NSA_WINDOW + jnp.arange(Q_BLOCK + NSA_WINDOW)
        mask_w = ((wpos[None, :] <= t[:, None]) & (wpos[None, :] > t[:, None] - NSA_WINDOW) &
                  (wpos[None, :] >= 0))
        s_w = jnp.einsum('bqgid,bjgd->bgiqj', qb, kwb) * scale
        p_w = masked_softmax(s_w, mask_w)
        o_w = jnp.einsum('bgiqj,bjgd->bqgid', p_w.astype(vwb.dtype), vwb)
        o = (gb[:, :, 0, :, :, None] * o_c + gb[:, :, 1, :, :, None] * o_s +
             gb[:, :, 2, :, :, None] * o_w)
        return o.reshape(Bsz, Q_BLOCK, NSA_Q_W)

    out = lax.map(block, jnp.arange(T // Q_BLOCK))
    return out.transpose(1, 0, 2, 3).reshape(Bsz, T, NSA_Q_W)


def moba_attention(q, k, v):
    Bsz, T, H, D = q.shape
    n_blk = -(-T // MOBA_BLOCK)
    pad = n_blk * MOBA_BLOCK - T
    k_pad = jnp.pad(k, ((0, 0), (0, pad), (0, 0), (0, 0)))
    v_pad = jnp.pad(v, ((0, 0), (0, pad), (0, 0), (0, 0)))
    k_blk = k_pad.reshape(Bsz, n_blk, MOBA_BLOCK, H, D)
    k_mean = jnp.mean(k_blk.astype(jnp.float32), axis=2).astype(k.dtype)
    k_blk = k_blk.transpose(0, 3, 1, 2, 4)
    v_blk = v_pad.reshape(Bsz, n_blk, MOBA_BLOCK, H, D).transpose(0, 3, 1, 2, 4)
    top = max(1, min(MOBA_TOPK, n_blk - 1))
    scale = HEAD_DIM ** -0.5
    b_idx = jnp.arange(Bsz)[:, None, None, None]
    h_idx = jnp.arange(H)[None, :, None, None]
    blocks = jnp.arange(n_blk)

    def block(bi):
        t0 = bi * Q_BLOCK
        t = t0 + jnp.arange(Q_BLOCK)
        cur = t0 // MOBA_BLOCK
        qb = lax.dynamic_slice_in_dim(q, t0, Q_BLOCK, axis=1)
        gate = jnp.einsum('bqhd,bnhd->bhqn', qb, k_mean).astype(jnp.float32)
        gate = jnp.where(blocks < cur, gate, NEG_INF)
        _, sel = lax.top_k(gate, top)
        k_g = k_blk[b_idx, h_idx, sel]
        v_g = v_blk[b_idx, h_idx, sel]
        s_sel = jnp.einsum('bqhd,bhqksd->bhqks', qb, k_g).reshape(Bsz, H, Q_BLOCK, top * MOBA_BLOCK)
        m_sel = jnp.broadcast_to((sel < cur)[..., None],
                                 (Bsz, H, Q_BLOCK, top, MOBA_BLOCK)).reshape(Bsz, H, Q_BLOCK, top * MOBA_BLOCK)
        k_own = lax.dynamic_slice_in_dim(k_pad, cur * MOBA_BLOCK, MOBA_BLOCK, axis=1)
        v_own = lax.dynamic_slice_in_dim(v_pad, cur * MOBA_BLOCK, MOBA_BLOCK, axis=1)
        s_own = jnp.einsum('bqhd,bshd->bhqs', qb, k_own)
        own_pos = cur * MOBA_BLOCK + jnp.arange(MOBA_BLOCK)
        m_own = jnp.broadcast_to(own_pos[None, :] <= t[:, None], (Bsz, H, Q_BLOCK, MOBA_BLOCK))
        p = masked_softmax(jnp.concatenate([s_sel, s_own], axis=-1) * scale,
                           jnp.concatenate([m_sel, m_own], axis=-1)).astype(v.dtype)
        p_sel = p[..., :top * MOBA_BLOCK].reshape(Bsz, H, Q_BLOCK, top, MOBA_BLOCK)
        p_own = p[..., top * MOBA_BLOCK:]
        o = (jnp.einsum('bhqks,bhqksd->bqhd', p_sel, v_g) +
             jnp.einsum('bhqs,bshd->bqhd', p_own, v_own))
        return o.reshape(Bsz, Q_BLOCK, H * D)

    out = lax.map(block, jnp.arange(T // Q_BLOCK))
    return out.transpose(1, 0, 2, 3).reshape(Bsz, T, H * D)


def memory_attention(q, mem_n, w_mem_kv):
    Bsz, T = q.shape[0], q.shape[1]
    k, v = jnp.split(mem_n @ w_mem_kv, 2, axis=-1)
    k = k.reshape(Bsz, -1, MEM_HEADS, HEAD_DIM)
    v = v.reshape(Bsz, -1, MEM_HEADS, HEAD_DIM)
    s = jnp.einsum('bthd,bmhd->bhtm', q, k).astype(jnp.float32) * (HEAD_DIM ** -0.5)
    p = jax.nn.softmax(s, axis=-1).astype(v.dtype)
    return jnp.einsum('bhtm,bmhd->bthd', p, v).reshape(Bsz, T, MEM_W)


def retention(q, k, v):
    Bsz, T, H, _ = q.shape
    C = RET_CHUNK
    NC = T // C
    log_g = jnp.log(1.0 - 2.0 ** (-5.0 - jnp.arange(H, dtype=jnp.float32)))
    i = jnp.arange(C, dtype=jnp.float32)
    diff = i[:, None] - i[None, :]
    decay = jnp.where(diff >= 0, jnp.exp(jnp.maximum(diff, 0.0)[None] * log_g[:, None, None]), 0.0)
    q_decay = jnp.exp((i + 1.0)[None, :] * log_g[:, None])
    k_decay = jnp.exp((C - 1.0 - i)[None, :] * log_g[:, None])
    chunk_decay = jnp.exp(C * log_g)

    def to_chunks(a):
        return a.astype(jnp.float32).reshape(Bsz, NC, C, H, -1).transpose(1, 0, 3, 2, 4)

    def step(state, inp):
        qc, kc, vc = inp
        inner = jnp.einsum('bhid,bhjd->bhij', qc, kc) * decay
        o = (jnp.einsum('bhij,bhjv->bhiv', inner, vc) +
             jnp.einsum('bhid,bhdv->bhiv', qc, state) * q_decay[None, :, :, None])
        state = (state * chunk_decay[None, :, None, None] +
                 jnp.einsum('bhjd,bhjv->bhdv', kc * k_decay[None, :, :, None], vc))
        return state, o

    state0 = jnp.zeros((Bsz, H, q.shape[-1], v.shape[-1]), jnp.float32)
    _, o = lax.scan(step, state0, (to_chunks(q), to_chunks(k), to_chunks(v)))
    return o.transpose(1, 0, 3, 2, 4).reshape(Bsz, T, H, v.shape[-1])


def head_group_norm(o):
    mu = jnp.mean(o, axis=-1, keepdims=True)
    var = jnp.mean(jnp.square(o - mu), axis=-1, keepdims=True)
    return (o - mu) * lax.rsqrt(var + NORM_EPS)


def even_layer(x, mem_n, cos, sin, norm_g, w_in, gate_b, pe_k, w1_k, w2_k, pe_v, w1_v, w2_v, w_mem_kv, w_out):
    Bsz, T, _ = x.shape
    h = rms_norm(x, norm_g)
    (nq, nkc, nvc, nks, nvs, nkw, nvw, ng, nz, mq, mk, mv, mz, eq, ez) = _split(h @ w_in, EVEN_SPLITS)

    def heads(a):
        return a.reshape(Bsz, T, -1, HEAD_DIM)

    def rot(a):
        return apply_rotary(heads(a), cos, sin)

    kc = nsa_compress(rot(nkc), pe_k, w1_k, w2_k)
    vc = nsa_compress(heads(nvc), pe_v, w1_v, w2_v)
    gates = jax.nn.sigmoid(ng + gate_b).reshape(Bsz, T, NSA_BRANCHES, NSA_HEADS)
    a_out = nsa_attention(rot(nq), kc, vc, rot(nks), heads(nvs), rot(nkw), heads(nvw), gates)
    b_out = moba_attention(rot(mq), rot(mk), heads(mv))
    m_out = memory_attention(heads(eq), mem_n, w_mem_kv)
    y = jnp.concatenate([a_out * jax.nn.silu(nz), b_out * jax.nn.silu(mz),
                         m_out * jax.nn.silu(ez)], axis=-1) @ w_out
    return x + y


def odd_layer(x, mem_n, rcos, rsin, norm_g, w_in, w_mem_kv, w_out):
    Bsz, T, _ = x.shape
    h = rms_norm(x, norm_g)
    rq, rk, rv, rz, eq, ez = _split(h @ w_in, ODD_SPLITS)
    q = apply_rotary(rq.reshape(Bsz, T, RET_HEADS, RET_QK_DIM), rcos, rsin)
    k = apply_rotary(rk.reshape(Bsz, T, RET_HEADS, RET_QK_DIM), rcos, rsin) * (RET_QK_DIM ** -0.5)
    v = rv.reshape(Bsz, T, RET_HEADS, RET_V_DIM)
    r_out = head_group_norm(retention(q, k, v)).reshape(Bsz, T, RET_V_W).astype(x.dtype)
    m_out = memory_attention(eq.reshape(Bsz, T, MEM_HEADS, HEAD_DIM), mem_n, w_mem_kv)
    y = jnp.concatenate([r_out * jax.nn.silu(rz), m_out * jax.nn.silu(ez)], axis=-1) @ w_out
    return x + y


def setup_inputs(seed: int = 0) -> dict:
    key = jax.random.key(seed)
    ks = jax.random.split(key, 24)

    def nrm(k, shape, scale):
        return jax.random.normal(k, shape, jnp.float32) * scale

    def gain(k):
        return 1.0 + nrm(k, (D_MODEL,), 0.02)

    x = nrm(ks[0], (BATCH, SEQ, D_MODEL), 1.0)
    mem = nrm(ks[1], (BATCH, MEM_LEN, D_MODEL), 1.0)
    positions = jnp.broadcast_to(jnp.arange(SEQ, dtype=jnp.int32)[None, :], (BATCH, SEQ))
    cmp_in = NSA_CMP_LEN * HEAD_DIM
    return {
        'x': x,
        'mem': mem,
        'positions': positions,
        'l0_norm_g': gain(ks[2]),
        'l0_w_in': nrm(ks[3], (D_MODEL, EVEN_IN_W), D_MODEL ** -0.5),
        'l0_nsa_gate_b': nrm(ks[4], (NSA_BRANCHES * NSA_HEADS,), 0.1),
        'l0_cmp_pe_k': nrm(ks[5], (NSA_CMP_LEN, HEAD_DIM), 0.1),
        'l0_cmp_w1_k': nrm(ks[6], (NSA_CMP_LEN, HEAD_DIM, HEAD_DIM), cmp_in ** -0.5),
        'l0_cmp_w2_k': nrm(ks[7], (HEAD_DIM, HEAD_DIM), HEAD_DIM ** -0.5),
        'l0_cmp_pe_v': nrm(ks[8], (NSA_CMP_LEN, HEAD_DIM), 0.1),
        'l0_cmp_w1_v': nrm(ks[9], (NSA_CMP_LEN, HEAD_DIM, HEAD_DIM), cmp_in ** -0.5),
        'l0_cmp_w2_v': nrm(ks[10], (HEAD_DIM, HEAD_DIM), HEAD_DIM ** -0.5),
        'l0_w_mem_kv': nrm(ks[11], (D_MODEL, 2 * MEM_W), D_MODEL ** -0.5),
        'l0_w_out': nrm(ks[12], (EVEN_OUT_W, D_MODEL), EVEN_OUT_W ** -0.5),
        'l1_norm_g': gain(ks[13]),
        'l1_w_in': nrm(ks[14], (D_MODEL, ODD_IN_W), D_MODEL ** -0.5),
        'l1_w_mem_kv': nrm(ks[15], (D_MODEL, 2 * MEM_W), D_MODEL ** -0.5),
        'l1_w_out': nrm(ks[16], (ODD_OUT_W, D_MODEL), ODD_OUT_W ** -0.5),
        'mem_norm_g': gain(ks[17]),
        'final_norm_g': gain(ks[18]),
    }


def reference(x, mem, positions, l0_norm_g, l0_w_in, l0_nsa_gate_b, l0_cmp_pe_k, l0_cmp_w1_k, l0_cmp_w2_k,
              l0_cmp_pe_v, l0_cmp_w1_v, l0_cmp_w2_v, l0_w_mem_kv, l0_w_out,
              l1_norm_g, l1_w_in, l1_w_mem_kv, l1_w_out, mem_norm_g, final_norm_g):
    attn_inv = 1.0 / (ROPE_THETA ** (jnp.arange(0, HEAD_DIM, 2, dtype=jnp.float32) / HEAD_DIM))
    ret_inv = 1.0 / (ROPE_THETA ** jnp.linspace(0.0, 1.0, RET_QK_DIM // 2, dtype=jnp.float32))
    cos, sin = rotary_tables(positions, attn_inv)
    rcos, rsin = rotary_tables(positions, ret_inv)
    mem_n = rms_norm(mem, mem_norm_g)
    layer_params = (
        (l0_norm_g, l0_w_in, l0_nsa_gate_b, l0_cmp_pe_k, l0_cmp_w1_k, l0_cmp_w2_k,
         l0_cmp_pe_v, l0_cmp_w1_v, l0_cmp_w2_v, l0_w_mem_kv, l0_w_out),
        (l1_norm_g, l1_w_in, l1_w_mem_kv, l1_w_out),
    )
    for layer in range(DEPTH):
        if layer % 2 == 0:
            x = even_layer(x, mem_n, cos, sin, *layer_params[layer])
        else:
            x = odd_layer(x, mem_n, rcos, rsin, *layer_params[layer])
    return rms_norm(x, final_norm_g)
```

```cpp
#include <hip/hip_runtime.h>
#include <hip/hip_cooperative_groups.h>
#include <cstdio>
namespace cg = cooperative_groups;

typedef unsigned short bf16_t;
typedef __attribute__((ext_vector_type(8))) short bf16x8;
typedef __attribute__((ext_vector_type(4))) short s16x4;
typedef __attribute__((ext_vector_type(4))) float f32x4;
#define DI __device__ __forceinline__
#define MFMA16(a, b, c) __builtin_amdgcn_mfma_f32_16x16x32_bf16((a), (b), (c), 0, 0, 0)

#ifndef DO_L0
#define DO_L0 1
#endif

constexpr int T = 16384;
constexpr int LD0 = 4480;
constexpr int C_NQ = 0, C_KCI = 512, C_VCI = 640, C_KS = 768, C_VS = 896, C_KW = 1024, C_VW = 1152, C_NZ = 1280,
              C_MQ = 1792, C_MK = 2304, C_MV = 2816, C_MZ = 3328, C_EQ = 3840, C_EZ = 4096, C_NG = 4352;
constexpr float QSCALE = 0.125f * 1.4426950408889634f;
constexpr size_t Mi = 1048576;
constexpr size_t OFF_Y0 = 0;
constexpr size_t OFF_RSTD0 = 32 * Mi;
constexpr size_t OFF_RSTD1 = OFF_RSTD0 + 65536;
constexpr size_t OFF_MEMN = OFF_RSTD1 + 65536;
constexpr size_t OFF_MEMK0 = OFF_MEMN + 524288;
constexpr size_t OFF_MEMVT0 = OFF_MEMK0 + 131072;
constexpr size_t OFF_MEMK1 = OFF_MEMVT0 + 131072;
constexpr size_t OFF_MEMVT1 = OFF_MEMK1 + 131072;
constexpr size_t OFF_WMEM0T = 33 * Mi + 512 * 1024;
constexpr size_t OFF_WMEM1T = OFF_WMEM0T + Mi;
constexpr size_t RG = 36 * Mi;
constexpr size_t OFF_WT0 = RG;
constexpr size_t OFF_WOUT0T = RG + 9 * Mi;
constexpr size_t OFF_W1KT = RG + 12 * Mi;
constexpr size_t OFF_W1VT = OFF_W1KT + 262144;
constexpr size_t OFF_W2KT = OFF_W1VT + 262144;
constexpr size_t OFF_W2VT = OFF_W2KT + 8192;
constexpr size_t OFF_CBIAS = OFF_W2VT + 8192;
constexpr size_t OFF_KMEAN = OFF_CBIAS + 1024;
constexpr size_t OFF_KC = RG + 13 * Mi;
constexpr size_t OFF_VCT = OFF_KC + 262144;
constexpr size_t OFF_HID = OFF_VCT + 262144;
constexpr size_t OFF_ROPE0C = RG + 14 * Mi;
constexpr size_t OFF_ROPE0S = RG + 16 * Mi;
constexpr size_t OFF_NG = RG + 18 * Mi;
constexpr size_t OFF_VST = RG + 20 * Mi;
constexpr size_t OFF_VWT = RG + 24 * Mi;
constexpr size_t OFF_MVT = RG + 28 * Mi;
constexpr size_t OFF_PR0 = RG + 44 * Mi;
constexpr size_t OFF_WRZT = RG;
constexpr size_t OFF_WOUT1T = RG + 4 * Mi;
constexpr size_t OFF_EQ1 = RG + 9 * Mi;
constexpr size_t OFF_EZ1 = RG + 17 * Mi;
constexpr size_t OFF_KP = RG + 25 * Mi;
constexpr size_t OFF_KPT = RG + 57 * Mi;
constexpr size_t OFF_O = OFF_KP;
constexpr size_t OFF_VT = RG + 89 * Mi;
constexpr size_t OFF_Z = OFF_VT;
constexpr size_t OFF_S = RG + 153 * Mi;
constexpr size_t OFF_ROPE1C = OFF_S;
constexpr size_t OFF_ROPE1S = OFF_S + 8 * Mi;
constexpr size_t OFF_WT1 = OFF_S + 16 * Mi;
constexpr size_t DOFF_P = 32 * Mi;

struct Params {
  const float* x; const float* mem; const int* pos;
  const float *l0_g, *l0_win, *l0_gb, *pe_k, *w1_k, *w2_k, *pe_v, *w1_v, *w2_v, *l0_wmem, *l0_wout;
  const float *l1_g, *l1_win, *l1_wmem, *l1_wout, *mem_g, *fin_g;
  float* out; char* ws;
};

DI bf16_t f2bf(float f) { unsigned u = __float_as_uint(f); u += 0x7fffu + ((u >> 16) & 1u); return (bf16_t)(u >> 16); }
DI float bf2f(bf16_t h) { return __uint_as_float(((unsigned)h) << 16); }
DI unsigned pack2(float a, float b) { return (unsigned)f2bf(a) | ((unsigned)f2bf(b) << 16); }
DI float bflo(unsigned u) { return __uint_as_float(u << 16); }
DI float bfhi(unsigned u) { return __uint_as_float(u & 0xffff0000u); }
DI float silu_f(float x) { return x / (1.f + __expf(-x)); }
DI float sigm_f(float x) { return 1.f / (1.f + __expf(-x)); }
DI float ex2(float x) { return __builtin_amdgcn_exp2f(x); }
DI void wave_lds_sync() { asm volatile("s_waitcnt lgkmcnt(0)" ::: "memory"); }
DI uint2 pack4(f32x4 v) { uint2 r; r.x = pack2(v[0], v[1]); r.y = pack2(v[2], v[3]); return r; }

template <int WM, int WN, bool SWAP, class LA, class LB>
DI void gemm_tile(f32x4 (&acc)[WM][WN], int nk, LA loadA, LB loadB, bf16_t* smem) {
  constexpr int BM = WM * 32, BN = WN * 32, LD = 40, NA = BM / 64, NB = BN / 64;
  bf16_t* sA = smem;
  bf16_t* sB = smem + 2 * BM * LD;
  const int tid = threadIdx.x, lane = tid & 63, wave = tid >> 6, wm = wave >> 1, wn = wave & 1;
  const int r16 = lane & 15, quad = lane >> 4;
  uint4 ra[NA], rb[NB];
#pragma unroll
  for (int i = 0; i < NA; i++) { int idx = tid + i * 256; ra[i] = loadA(0, idx >> 2, idx & 3); }
#pragma unroll
  for (int i = 0; i < NB; i++) { int idx = tid + i * 256; rb[i] = loadB(0, idx >> 2, idx & 3); }
#pragma unroll
  for (int i = 0; i < NA; i++) { int idx = tid + i * 256; *(uint4*)(sA + (idx >> 2) * LD + (idx & 3) * 8) = ra[i]; }
#pragma unroll
  for (int i = 0; i < NB; i++) { int idx = tid + i * 256; *(uint4*)(sB + (idx >> 2) * LD + (idx & 3) * 8) = rb[i]; }
  __syncthreads();
  for (int kt = 0; kt < nk; kt++) {
    const int cur = kt & 1;
    if (kt + 1 < nk) {
#pragma unroll
      for (int i = 0; i < NA; i++) { int idx = tid + i * 256; ra[i] = loadA(kt + 1, idx >> 2, idx & 3); }
#pragma unroll
      for (int i = 0; i < NB; i++) { int idx = tid + i * 256; rb[i] = loadB(kt + 1, idx >> 2, idx & 3); }
    }
    const bf16_t* ab = sA + cur * BM * LD + (wm * WM * 16 + r16) * LD + quad * 8;
    const bf16_t* bb = sB + cur * BN * LD + (wn * WN * 16 + r16) * LD + quad * 8;
    bf16x8 af[WM], bfr[WN];
#pragma unroll
    for (int i = 0; i < WM; i++) af[i] = *(const bf16x8*)(ab + i * 16 * LD);
#pragma unroll
    for (int j = 0; j < WN; j++) bfr[j] = *(const bf16x8*)(bb + j * 16 * LD);
#pragma unroll
    for (int i = 0; i < WM; i++)
#pragma unroll
      for (int j = 0; j < WN; j++)
        acc[i][j] = SWAP ? MFMA16(bfr[j], af[i], acc[i][j]) : MFMA16(af[i], bfr[j], acc[i][j]);
    if (kt + 1 < nk) {
      bf16_t* sAn = sA + (cur ^ 1) * BM * LD;
      bf16_t* sBn = sB + (cur ^ 1) * BN * LD;
#pragma unroll
      for (int i = 0; i < NA; i++) { int idx = tid + i * 256; *(uint4*)(sAn + (idx >> 2) * LD + (idx & 3) * 8) = ra[i]; }
#pragma unroll
      for (int i = 0; i < NB; i++) { int idx = tid + i * 256; *(uint4*)(sBn + (idx >> 2) * LD + (idx & 3) * 8) = rb[i]; }
    }
    __syncthreads();
  }
}

template <int WM, int WN>
DI void zero_acc(f32x4 (&acc)[WM][WN]) {
#pragma unroll
  for (int i = 0; i < WM; i++)
#pragma unroll
    for (int j = 0; j < WN; j++) acc[i][j] = (f32x4){0.f, 0.f, 0.f, 0.f};
}

DI uint4 ld_bf(const bf16_t* base, size_t ld, int row, int kt, int ch) {
  return *(const uint4*)(base + (size_t)row * ld + kt * 32 + ch * 8);
}
DI uint4 ld_norm(const float* x, const bf16_t* y0, const float* rstd, const float* g, int t, int kt, int ch) {
  const int k = kt * 32 + ch * 8;
  const float4* xp = (const float4*)(x + (size_t)t * 1024 + k);
  float4 a = xp[0], b = xp[1];
  if (y0) {
    uint4 yv = *(const uint4*)(y0 + (size_t)t * 1024 + k);
    a.x += bflo(yv.x); a.y += bfhi(yv.x); a.z += bflo(yv.y); a.w += bfhi(yv.y);
    b.x += bflo(yv.z); b.y += bfhi(yv.z); b.z += bflo(yv.w); b.w += bfhi(yv.w);
  }
  const float rs = rstd[t];
  const float4* gp = (const float4*)(g + k);
  float4 g0 = gp[0], g1 = gp[1];
  uint4 r;
  r.x = pack2(a.x * rs * g0.x, a.y * rs * g0.y); r.y = pack2(a.z * rs * g0.z, a.w * rs * g0.w);
  r.z = pack2(b.x * rs * g1.x, b.y * rs * g1.y); r.w = pack2(b.z * rs * g1.z, b.w * rs * g1.w);
  return r;
}

template <class CM>
DI void transpose_w(const float* src, int K, int srcN, bf16_t* dst, int Npad, CM cm, float* sm, int bid, int nb) {
  const int tid = threadIdx.x, tx = tid & 63, ty = tid >> 6;
  const int tilesK = K / 64, tilesN = Npad / 64;
  for (int it = bid; it < tilesK * tilesN; it += nb) {
    const int n0 = (it / tilesK) * 64, k0 = (it % tilesK) * 64;
    const int sc = cm(n0 + tx);
#pragma unroll 4
    for (int i = 0; i < 16; i++) {
      int kk = ty + i * 4;
      sm[kk * 65 + tx] = sc >= 0 ? src[(size_t)(k0 + kk) * srcN + sc] : 0.f;
    }
    __syncthreads();
#pragma unroll 4
    for (int i = 0; i < 16; i++) {
      int nn = ty + i * 4;
      dst[(size_t)(n0 + nn) * K + k0 + tx] = f2bf(sm[tx * 65 + nn]);
    }
    __syncthreads();
  }
}

DI void row_rstd(const float* x, const bf16_t* y0, float* rstd, int rows, int gw, int nw, int lane) {
  for (int t = gw; t < rows; t += nw) {
    const float4* xp = (const float4*)(x + (size_t)t * 1024);
    float s = 0.f;
#pragma unroll
    for (int i = 0; i < 4; i++) {
      float4 v = xp[lane + i * 64];
      if (y0) {
        uint2 yv = *(const uint2*)(y0 + (size_t)t * 1024 + (lane + i * 64) * 4);
        v.x += bflo(yv.x); v.y += bfhi(yv.x); v.z += bflo(yv.y); v.w += bfhi(yv.y);
      }
      s += v.x * v.x + v.y * v.y + v.z * v.z + v.w * v.w;
    }
#pragma unroll
    for (int o = 32; o > 0; o >>= 1) s += __shfl_xor(s, o);
    if (lane == 0) rstd[t] = rsqrtf(s * (1.f / 1024.f) + 1e-6f);
  }
}

struct AttnSt { float m, l; f32x4 o[4]; };
DI void attn_init(AttnSt& s) {
  s.m = -1e30f; s.l = 0.f;
#pragma unroll
  for (int i = 0; i < 4; i++) s.o[i] = (f32x4){0.f, 0.f, 0.f, 0.f};
}
DI f32x4 qk16(const bf16_t* K, int ks, int key0, bf16x8 q0, bf16x8 q1, int lane) {
  const bf16_t* kp = K + (size_t)(key0 + (lane & 15)) * ks + (lane >> 4) * 8;
  bf16x8 k0 = *(const bf16x8*)kp;
  bf16x8 k1 = *(const bf16x8*)(kp + 32);
  f32x4 s = {0.f, 0.f, 0.f, 0.f};
  s = MFMA16(k0, q0, s);
  s = MFMA16(k1, q1, s);
  return s;
}
template <class MF>
DI void attn_step(const bf16_t* K, int ks, const bf16_t* Vt, int vs, int key0, bf16x8 q0, bf16x8 q1, AttnSt& st,
                  MF maskf, int lane) {
  const int r16 = lane & 15, quad = lane >> 4;
  f32x4 sa = qk16(K, ks, key0, q0, q1, lane);
  f32x4 sb = qk16(K, ks, key0 + 16, q0, q1, lane);
  const bf16_t* vp = Vt + (size_t)r16 * vs + key0 + quad * 4;
  s16x4 va[4], vb[4];
#pragma unroll
  for (int dt = 0; dt < 4; dt++) {
    va[dt] = *(const s16x4*)(vp + (size_t)dt * 16 * vs);
    vb[dt] = *(const s16x4*)(vp + (size_t)dt * 16 * vs + 16);
  }
  bool ma[4], mb[4];
  float mx = -1e30f;
#pragma unroll
  for (int r = 0; r < 4; r++) {
    ma[r] = maskf(key0 + quad * 4 + r);
    mb[r] = maskf(key0 + 16 + quad * 4 + r);
    if (ma[r]) mx = fmaxf(mx, sa[r]);
    if (mb[r]) mx = fmaxf(mx, sb[r]);
  }
  mx = fmaxf(mx, __shfl_xor(mx, 16));
  mx = fmaxf(mx, __shfl_xor(mx, 32));
  const float mn = fmaxf(st.m, mx);
  const float alpha = ex2(st.m - mn);
  float pa[4], pb[4], rs = 0.f;
#pragma unroll
  for (int r = 0; r < 4; r++) {
    pa[r] = ma[r] ? ex2(sa[r] - mn) : 0.f;
    pb[r] = mb[r] ? ex2(sb[r] - mn) : 0.f;
    rs += pa[r] + pb[r];
  }
  rs += __shfl_xor(rs, 16);
  rs += __shfl_xor(rs, 32);
  st.l = st.l * alpha + rs;
  st.m = mn;
  bf16x8 pf;
#pragma unroll
  for (int r = 0; r < 4; r++) { pf[r] = (short)f2bf(pa[r]); pf[4 + r] = (short)f2bf(pb[r]); }
#pragma unroll
  for (int dt = 0; dt < 4; dt++) {
    bf16x8 vf = __builtin_shufflevector(va[dt], vb[dt], 0, 1, 2, 3, 4, 5, 6, 7);
    f32x4 o = st.o[dt];
    o[0] *= alpha; o[1] *= alpha; o[2] *= alpha; o[3] *= alpha;
    st.o[dt] = MFMA16(vf, pf, o);
  }
}
DI void load_q(const bf16_t* qrow, int lane, bf16x8& q0, bf16x8& q1) {
  q0 = *(const bf16x8*)(qrow + (lane >> 4) * 8);
  q1 = *(const bf16x8*)(qrow + 32 + (lane >> 4) * 8);
}

DI void mem_attn_item(const bf16_t* qsrc, int qld, const bf16_t* zsrc, int zld, bf16_t* dst, int dld,
                      const bf16_t* memK, const bf16_t* memVT, int t0, int h, int lane) {
  const int r16 = lane & 15, quad = lane >> 4;
  const int t = t0 + r16;
  bf16x8 q0, q1;
  load_q(qsrc + (size_t)t * qld + h * 64, lane, q0, q1);
  AttnSt st; attn_init(st);
  for (int key0 = 0; key0 < 256; key0 += 32)
    attn_step(memK + h * 64, 256, memVT + (size_t)h * 64 * 256, 256, key0, q0, q1, st, [](int) { return true; }, lane);
  const float inv = 1.f / fmaxf(st.l, 1e-30f);
#pragma unroll
  for (int dt = 0; dt < 4; dt++) {
    const int d = dt * 16 + quad * 4;
    uint2 zv = *(const uint2*)(zsrc + (size_t)t * zld + h * 64 + d);
    f32x4 o = st.o[dt];
    uint2 r;
    r.x = pack2(o[0] * inv * bflo(zv.x), o[1] * inv * bfhi(zv.x));
    r.y = pack2(o[2] * inv * bflo(zv.y), o[3] * inv * bfhi(zv.y));
    *(uint2*)(dst + (size_t)t * dld + h * 64 + d) = r;
  }
}

DI void moba_item(const bf16_t* PR0, const bf16_t* MVT, const bf16_t* KMEAN, bf16_t* CAT0, int t0, int h, int lane) {
  const int r16 = lane & 15, quad = lane >> 4;
  const int t = t0 + r16;
  const int cur = t0 >> 8;
  bf16x8 q0, q1;
  load_q(PR0 + (size_t)t * LD0 + C_MQ + h * 64, lane, q0, q1);
  unsigned long long k1 = 0, k2 = 0, k3 = 0;
  auto ins = [&](unsigned long long k) {
    unsigned long long a = k1 > k ? k1 : k, r = k1 > k ? k : k1;
    k1 = a;
    a = k2 > r ? k2 : r; r = k2 > r ? r : k2;
    k2 = a;
    k3 = k3 > r ? k3 : r;
  };
  if (cur > 0) {
#pragma unroll
    for (int kt = 0; kt < 4; kt++) {
      f32x4 s = qk16(KMEAN + h * 64, 512, kt * 16, q0, q1, lane);
#pragma unroll
      for (int r = 0; r < 4; r++) {
        const int n = kt * 16 + quad * 4 + r;
        unsigned u = __float_as_uint(s[r]);
        u = (u & 0x80000000u) ? ~u : (u | 0x80000000u);
        unsigned long long key = (((unsigned long long)u) << 8) | (unsigned)(63 - n);
        if (n < cur) ins(key);
      }
    }
#pragma unroll
    for (int off = 16; off <= 32; off <<= 1) {
      unsigned long long o1, o2, o3;
      o1 = ((unsigned long long)__shfl_xor((unsigned)(k1 >> 32), off) << 32) | __shfl_xor((unsigned)k1, off);
      o2 = ((unsigned long long)__shfl_xor((unsigned)(k2 >> 32), off) << 32) | __shfl_xor((unsigned)k2, off);
      o3 = ((unsigned long long)__shfl_xor((unsigned)(k3 >> 32), off) << 32) | __shfl_xor((unsigned)k3, off);
      ins(o1); ins(o2); ins(o3);
    }
  }
  unsigned long long msk = 0;
  if (k1) msk |= 1ull << (63 - (int)(k1 & 0xff));
  if (k2) msk |= 1ull << (63 - (int)(k2 & 0xff));
  if (k3) msk |= 1ull << (63 - (int)(k3 & 0xff));
  AttnSt st; attn_init(st);
  const bf16_t* Kb = PR0 + C_MK + h * 64;
  const bf16_t* Vb = MVT + (size_t)h * 64 * T;
  for (int n = 0; n < cur; n++) {
    const bool mine = (msk >> n) & 1ull;
    if (__ballot(mine) == 0ull) continue;
    for (int key0 = n * 256; key0 < n * 256 + 256; key0 += 32)
      attn_step(Kb, LD0, Vb, T, key0, q0, q1, st, [&](int) { return mine; }, lane);
  }
  for (int key0 = cur * 256; key0 <= t0 + 15; key0 += 32)
    attn_step(Kb, LD0, Vb, T, key0, q0, q1, st, [&](int key) { return key <= t; }, lane);
  const float inv = 1.f / fmaxf(st.l, 1e-30f);
#pragma unroll
  for (int dt = 0; dt < 4; dt++) {
    const int d = dt * 16 + quad * 4;
    uint2 zv = *(const uint2*)(PR0 + (size_t)t * LD0 + C_MZ + h * 64 + d);
    f32x4 o = st.o[dt];
    uint2 r;
    r.x = pack2(o[0] * inv * bflo(zv.x), o[1] * inv * bfhi(zv.x));
    r.y = pack2(o[2] * inv * bflo(zv.y), o[3] * inv * bfhi(zv.y));
    *(uint2*)(CAT0 + (size_t)t * 1280 + 512 + h * 64 + d) = r;
  }
}

DI void nsa_item(const bf16_t* PR0, const bf16_t* KC, const bf16_t* VCT, const bf16_t* VST, const bf16_t* VWT,
                 const float* NG, bf16_t* CAT0, int t0, int g, float* impw, unsigned* selw, int lane) {
  const int r16 = lane & 15, quad = lane >> 4;
  const int ql = r16 >> 2, hd = r16 & 3, H = g * 4 + hd;
  const int t = t0 + ql;
  const int cur = t0 >> 6;
  bf16x8 q0, q1;
  load_q(PR0 + (size_t)t * LD0 + C_NQ + H * 64, lane, q0, q1);
  const int nmax = (t >= 31) ? ((t - 31) >> 4) : -1;
  const int nmax_tile = (t0 + 3 >= 31) ? ((t0 + 3 - 31) >> 4) : -1;
  const bf16_t* Kc = KC + g * 64;
  const bf16_t* Vc = VCT + (size_t)g * 64 * 1024;
  AttnSt sc; attn_init(sc);
  for (int key0 = 0; key0 <= nmax_tile; key0 += 32)
    attn_step(Kc, 128, Vc, 1024, key0, q0, q1, sc, [&](int n) { return n <= nmax; }, lane);
  if (cur >= 3) {
    const float invl = 1.f / fmaxf(sc.l, 1e-30f);
    float carry = 0.f;
    for (int key0 = 0; key0 <= nmax_tile; key0 += 32) {
      f32x4 sa = qk16(Kc, 128, key0, q0, q1, lane);
      f32x4 sb = qk16(Kc, 128, key0 + 16, q0, q1, lane);
      float xa = 0.f, xb = 0.f, ea = 0.f, eb = 0.f;
#pragma unroll
      for (int r = 0; r < 4; r++) {
        float pa = (key0 + quad * 4 + r <= nmax) ? ex2(sa[r] - sc.m) * invl : 0.f;
        float pb = (key0 + 16 + quad * 4 + r <= nmax) ? ex2(sb[r] - sc.m) * invl : 0.f;
        xa += pa; xb += pb;
        if (r == 3) { ea = pa; eb = pb; }
      }
      const float ea_up = __shfl(ea, (lane - 16) & 63);
      const float eb_up = __shfl(eb, (lane - 16) & 63);
      const float ea_q3 = __shfl(ea, r16 + 48);
      const float eb_q3 = __shfl(eb, r16 + 48);
      float ia = xa + (quad > 0 ? ea_up : carry);
      float ib = xb + (quad > 0 ? eb_up : ea_q3);
      carry = eb_q3;
      ia += __shfl_xor(ia, 1); ia += __shfl_xor(ia, 2);
      ib += __shfl_xor(ib, 1); ib += __shfl_xor(ib, 2);
      if (hd == 0) {
        impw[ql * 256 + (key0 >> 2) + quad] = ia;
        impw[ql * 256 + (key0 >> 2) + 4 + quad] = ib;
      }
    }
  }
  wave_lds_sync();
  {
    const int nforced = cur == 0 ? 1 : (cur == 1 ? 2 : 3);
    const int R = 16 - nforced;
    const int hi = cur - 2;
    const int cnt = hi >= 1 ? hi : 0;
    for (int qq = 0; qq < 4; qq++) {
      float v0 = -1.f, v1 = -1.f, v2 = -1.f, v3 = -1.f;
      const int sb = lane * 4;
      if (cnt > 0) {
        f32x4 iv = *(const f32x4*)(impw + qq * 256 + sb);
        if (sb + 0 >= 1 && sb + 0 <= hi) v0 = iv[0];
        if (sb + 1 >= 1 && sb + 1 <= hi) v1 = iv[1];
        if (sb + 2 >= 1 && sb + 2 <= hi) v2 = iv[2];
        if (sb + 3 >= 1 && sb + 3 <= hi) v3 = iv[3];
      }
      unsigned nib = 0;
      if (cnt <= R) {
        nib = (v0 >= 0.f ? 1u : 0u) | (v1 >= 0.f ? 2u : 0u) | (v2 >= 0.f ? 4u : 0u) | (v3 >= 0.f ? 8u : 0u);
      } else {
        for (int round = 0; round < R; round++) {
          float bv = v0; int bi = 0;
          if (v1 > bv) { bv = v1; bi = 1; }
          if (v2 > bv) { bv = v2; bi = 2; }
          if (v3 > bv) { bv = v3; bi = 3; }
          unsigned kh = bv >= 0.f ? (__float_as_uint(bv) | 0x80000000u) : 0u;
          unsigned kl = 255u - (unsigned)(sb + bi);
#pragma unroll
          for (int off = 32; off > 0; off >>= 1) {
            unsigned oh = __shfl_xor(kh, off), ol = __shfl_xor(kl, off);
            if (oh > kh || (oh == kh && ol > kl)) { kh = oh; kl = ol; }
          }
          if (kh == 0u) break;
          const int sw = 255 - (int)kl;
          if ((sw >> 2) == lane) {
            const int i = sw & 3;
            if (i == 0) v0 = -1.f; else if (i == 1) v1 = -1.f; else if (i == 2) v2 = -1.f; else v3 = -1.f;
            nib |= 1u << i;
          }
        }
      }
      unsigned w = nib << ((lane & 7) * 4);
      w |= __shfl_xor(w, 1); w |= __shfl_xor(w, 2); w |= __shfl_xor(w, 4);
      const int wi = lane >> 3;
      if (wi == 0) w |= 1u;
      if ((cur >> 5) == wi) w |= 1u << (cur & 31);
      if (cur >= 1 && ((cur - 1) >> 5) == wi) w |= 1u << ((cur - 1) & 31);
      if ((lane & 7) == 0) selw[qq * 8 + wi] = w;
    }
  }
  wave_lds_sync();
  AttnSt ss; attn_init(ss);
  {
    const bf16_t* Kb = PR0 + C_KS + g * 64;
    const bf16_t* Vb = VST + (size_t)g * 64 * T;
    for (int s = 0; s <= cur; s++) {
      const unsigned w = selw[ql * 8 + (s >> 5)];
      const bool mine = (w >> (s & 31)) & 1u;
      if (__ballot(mine) == 0ull) continue;
      for (int key0 = s * 64; key0 < s * 64 + 64; key0 += 32) {
        if (key0 > t0 + 3) break;
        attn_step(Kb, LD0, Vb, T, key0, q0, q1, ss, [&](int key) { return mine && key <= t; }, lane);
      }
    }
  }
  AttnSt sw_; attn_init(sw_);
  {
    const bf16_t* Kb = PR0 + C_KW + g * 64;
    const bf16_t* Vb = VWT + (size_t)g * 64 * T;
    int start = t0 - 511; if (start < 0) start = 0;
    start &= ~31;
    for (int key0 = start; key0 <= t0 + 3; key0 += 32)
      attn_step(Kb, LD0, Vb, T, key0, q0, q1, sw_, [&](int key) { return key <= t && key > t - 512; }, lane);
  }
  const float gc = NG[t * 32 + H] / fmaxf(sc.l, 1e-30f);
  const float gs = NG[t * 32 + 8 + H] / fmaxf(ss.l, 1e-30f);
  const float gw = NG[t * 32 + 16 + H] / fmaxf(sw_.l, 1e-30f);
#pragma unroll
  for (int dt = 0; dt < 4; dt++) {
    const int d = dt * 16 + quad * 4;
    uint2 zv = *(const uint2*)(PR0 + (size_t)t * LD0 + C_NZ + H * 64 + d);
    f32x4 a = sc.o[dt], b = ss.o[dt], c = sw_.o[dt];
    uint2 r;
    r.x = pack2((gc * a[0] + gs * b[0] + gw * c[0]) * bflo(zv.x), (gc * a[1] + gs * b[1] + gw * c[1]) * bfhi(zv.x));
    r.y = pack2((gc * a[2] + gs * b[2] + gw * c[2]) * bflo(zv.y), (gc * a[3] + gs * b[3] + gw * c[3]) * bfhi(zv.y));
    *(uint2*)(CAT0 + (size_t)t * 1280 + H * 64 + d) = r;
  }
}

__global__ void __launch_bounds__(256) fwd_megakernel(Params p) {
  cg::grid_group grid = cg::this_grid();
  __shared__ __attribute__((aligned(16))) char smem_raw[40960];
  bf16_t* smem = (bf16_t*)smem_raw;
  const int tid = threadIdx.x, lane = tid & 63, wave = tid >> 6;
  const int r16 = lane & 15, quad = lane >> 4;
  const int wm = wave >> 1, wn = wave & 1;
  const int bid = blockIdx.x, nb = gridDim.x;
  const int gw = bid * 4 + wave, nw = nb * 4;
  const int gtid = bid * 256 + tid, nthr = nb * 256;
  char* ws = p.ws;
  bf16_t* Y0 = (bf16_t*)(ws + OFF_Y0);
  float* RSTD0 = (float*)(ws + OFF_RSTD0);
  float* RSTD1 = (float*)(ws + OFF_RSTD1);
  bf16_t* MEMN = (bf16_t*)(ws + OFF_MEMN);
  bf16_t* MEMK0 = (bf16_t*)(ws + OFF_MEMK0);
  bf16_t* MEMVT0 = (bf16_t*)(ws + OFF_MEMVT0);
  bf16_t* MEMK1 = (bf16_t*)(ws + OFF_MEMK1);
  bf16_t* MEMVT1 = (bf16_t*)(ws + OFF_MEMVT1);
  bf16_t* WMEM0T = (bf16_t*)(ws + OFF_WMEM0T);
  bf16_t* WMEM1T = (bf16_t*)(ws + OFF_WMEM1T);
  bf16_t* dO = (bf16_t*)p.out;

  {
    for (int t = gw; t < 256; t += nw) {
      const float4* xp = (const float4*)(p.mem + (size_t)t * 1024);
      float4 v[4]; float s = 0.f;
#pragma unroll
      for (int i = 0; i < 4; i++) { v[i] = xp[lane + i * 64]; s += v[i].x * v[i].x + v[i].y * v[i].y + v[i].z * v[i].z + v[i].w * v[i].w; }
#pragma unroll
      for (int o = 32; o > 0; o >>= 1) s += __shfl_xor(s, o);
      const float rs = rsqrtf(s * (1.f / 1024.f) + 1e-6f);
#pragma unroll
      for (int i = 0; i < 4; i++) {
        float4 gg = ((const float4*)p.mem_g)[lane + i * 64];
        uint2 r; r.x = pack2(v[i].x * rs * gg.x, v[i].y * rs * gg.y); r.y = pack2(v[i].z * rs * gg.z, v[i].w * rs * gg.w);
        *(uint2*)(MEMN + (size_t)t * 1024 + (lane + i * 64) * 4) = r;
      }
    }
    transpose_w(p.l0_wmem, 1024, 512, WMEM0T, 512, [](int n) { return n; }, (float*)smem_raw, bid, nb);
    transpose_w(p.l1_wmem, 1024, 512, WMEM1T, 512, [](int n) { return n; }, (float*)smem_raw, bid, nb);
#if DO_L0
    row_rstd(p.x, nullptr, RSTD0, T, gw, nw, lane);
    transpose_w(p.l0_win, 1024, 4376, (bf16_t*)(ws + OFF_WT0), 4480,
                [](int n) { return n < 1280 ? n : (n < 4352 ? n + 24 : (n < 4376 ? n - 4352 + 1280 : -1)); },
                (float*)smem_raw, bid, nb);
    transpose_w(p.l0_wout, 1280, 1024, (bf16_t*)(ws + OFF_WOUT0T), 1024, [](int n) { return n; }, (float*)smem_raw, bid, nb);
    transpose_w(p.w1_k, 2048, 64, (bf16_t*)(ws + OFF_W1KT), 64, [](int n) { return n; }, (float*)smem_raw, bid, nb);
    transpose_w(p.w1_v, 2048, 64, (bf16_t*)(ws + OFF_W1VT), 64, [](int n) { return n; }, (float*)smem_raw, bid, nb);
    transpose_w(p.w2_k, 64, 64, (bf16_t*)(ws + OFF_W2KT), 64, [](int n) { return n; }, (float*)smem_raw, bid, nb);
    transpose_w(p.w2_v, 64, 64, (bf16_t*)(ws + OFF_W2VT), 64, [](int n) { return n; }, (float*)smem_raw, bid, nb);
    {
      float* RC = (float*)(ws + OFF_ROPE0C); float* RS = (float*)(ws + OFF_ROPE0S);
      for (int i = gtid; i < T * 32; i += nthr) {
        const int t = i >> 5, d = i & 31;
        const double inv = exp2(-(double)d / 32.0 * 13.287712379549449);
        const double ang = (double)p.pos[t] * inv;
        RC[i] = (float)cos(ang); RS[i] = (float)sin(ang);
      }
    }
    if (bid == nb - 1 && tid < 128) {
      const float* pe = tid < 64 ? p.pe_k : p.pe_v;
      const float* w1 = tid < 64 ? p.w1_k : p.w1_v;
      const int e = tid & 63;
      float s = 0.f;
      for (int k = 0; k < 2048; k++) s += pe[k] * w1[(size_t)k * 64 + e];
      ((float*)(ws + OFF_CBIAS))[tid] = s;
    }
#endif
  }
  grid.sync();

#if DO_L0
  {
    const bf16_t* WT0 = (const bf16_t*)(ws + OFF_WT0);
    bf16_t* PR0 = (bf16_t*)(ws + OFF_PR0);
    const float* RC = (const float*)(ws + OFF_ROPE0C); const float* RS = (const float*)(ws + OFF_ROPE0S);
    float* NG = (float*)(ws + OFF_NG);
    const int NT = 128 * 35;
    for (int it = bid; it < NT + 16; it += nb) {
      if (it >= NT) {
        const int j = it - NT, layer = j >> 3, tm = (j >> 2) & 1, tn = j & 3;
        const bf16_t* Wt = layer ? WMEM1T : WMEM0T;
        bf16_t* MK = layer ? MEMK1 : MEMK0; bf16_t* MV = layer ? MEMVT1 : MEMVT0;
        const int m0 = tm * 128, n0 = tn * 128;
        auto la = [&](int kt, int row, int ch) { return ld_bf(MEMN, 1024, m0 + row, kt, ch); };
        auto lb = [&](int kt, int row, int ch) { return ld_bf(Wt, 1024, n0 + row, kt, ch); };
        f32x4 acc[4][4]; zero_acc(acc);
        if (n0 < 256) {
          gemm_tile<4, 4, true>(acc, 32, la, lb, smem);
#pragma unroll
          for (int i = 0; i < 4; i++)
#pragma unroll
            for (int jj = 0; jj < 4; jj++) {
              const int m = m0 + wm * 64 + i * 16 + r16, n = n0 + wn * 64 + jj * 16 + quad * 4;
              *(uint2*)(MK + (size_t)m * 256 + n) = pack4(acc[i][jj]);
            }
        } else {
          gemm_tile<4, 4, false>(acc, 32, la, lb, smem);
#pragma unroll
          for (int i = 0; i < 4; i++)
#pragma unroll
            for (int jj = 0; jj < 4; jj++) {
              const int m = m0 + wm * 64 + i * 16 + quad * 4, n = n0 + wn * 64 + jj * 16 + r16 - 256;
              *(uint2*)(MV + (size_t)n * 256 + m) = pack4(acc[i][jj]);
            }
        }
        continue;
      }
      const int tn = it % 35, tm = it / 35;
      const int m0 = tm * 128, n0 = tn * 128;
      auto la = [&](int kt, int row, int ch) { return ld_norm(p.x, nullptr, RSTD0, p.l0_g, m0 + row, kt, ch); };
      auto lb = [&](int kt, int row, int ch) { return ld_bf(WT0, 1024, n0 + row, kt, ch); };
      f32x4 acc[4][4]; zero_acc(acc);
      const bool isT = (n0 == C_VS) || (n0 == C_VW) || (n0 >= C_MV && n0 < C_MZ);
      if (isT) {
        gemm_tile<4, 4, false>(acc, 32, la, lb, smem);
        bf16_t* dst; int nbase;
        if (n0 == C_VS) { dst = (bf16_t*)(ws + OFF_VST); nbase = C_VS; }
        else if (n0 == C_VW) { dst = (bf16_t*)(ws + OFF_VWT); nbase = C_VW; }
        else { dst = (bf16_t*)(ws + OFF_MVT); nbase = C_MV; }
#pragma unroll
        for (int i = 0; i < 4; i++)
#pragma unroll
          for (int jj = 0; jj < 4; jj++) {
            const int m = m0 + wm * 64 + i * 16 + quad * 4, n = n0 + wn * 64 + jj * 16 + r16 - nbase;
            *(uint2*)(dst + (size_t)n * T + m) = pack4(acc[i][jj]);
          }
      } else {
        gemm_tile<4, 4, true>(acc, 32, la, lb, smem);
        const int nbw = n0 + wn * 64;
        const bool rope = (nbw < 640) || (nbw >= C_KS && nbw < C_VS) || (nbw >= C_KW && nbw < C_VW) || (nbw >= C_MQ && nbw < C_MV);
        const bool qs = (nbw < 512) || (nbw >= C_MQ && nbw < C_MK) || (nbw >= C_EQ && nbw < C_EZ);
        const bool sl = (nbw >= C_NZ && nbw < C_MQ) || (nbw >= C_MZ && nbw < C_EQ) || (nbw >= C_EZ && nbw < C_NG);
#pragma unroll
        for (int i = 0; i < 4; i++) {
          const int t = m0 + wm * 64 + i * 16 + r16;
          if (n0 == C_NG) {
            if (wn == 0) {
#pragma unroll
              for (int jj = 0; jj < 2; jj++)
#pragma unroll
                for (int r = 0; r < 4; r++) {
                  const int idx = jj * 16 + quad * 4 + r;
                  if (idx < 24) NG[t * 32 + idx] = sigm_f(acc[i][jj][r] + p.l0_gb[idx]);
                }
            }
            continue;
          }
          if (rope) {
#pragma unroll
            for (int jj = 0; jj < 2; jj++) {
              const int d0 = jj * 16 + quad * 4;
              const f32x4 cc = *(const f32x4*)(RC + t * 32 + d0);
              const f32x4 ssn = *(const f32x4*)(RS + t * 32 + d0);
              f32x4 x1 = acc[i][jj], x2 = acc[i][jj + 2];
#pragma unroll
              for (int r = 0; r < 4; r++) {
                acc[i][jj][r] = x1[r] * cc[r] - x2[r] * ssn[r];
                acc[i][jj + 2][r] = x1[r] * ssn[r] + x2[r] * cc[r];
              }
            }
          }
#pragma unroll
          for (int jj = 0; jj < 4; jj++) {
            f32x4 v = acc[i][jj];
            if (qs) { v[0] *= QSCALE; v[1] *= QSCALE; v[2] *= QSCALE; v[3] *= QSCALE; }
            if (sl) { v[0] = silu_f(v[0]); v[1] = silu_f(v[1]); v[2] = silu_f(v[2]); v[3] = silu_f(v[3]); }
            *(uint2*)(PR0 + (size_t)t * LD0 + nbw + jj * 16 + quad * 4) = pack4(v);
          }
        }
      }
    }
  }
  grid.sync();

  {
    const bf16_t* PR0 = (const bf16_t*)(ws + OFF_PR0);
    bf16_t* KMEAN = (bf16_t*)(ws + OFF_KMEAN);
    bf16_t* HID = (bf16_t*)(ws + OFF_HID);
    const float* CB = (const float*)(ws + OFF_CBIAS);
    for (int it = bid; it < 64 + 128; it += nb) {
      if (it >= 64) {
        const int idx = (it - 64) * 256 + tid;
        const int n = idx >> 9, hd_ = idx & 511;
        float s = 0.f;
        for (int r = 0; r < 256; r++) s += bf2f(PR0[(size_t)(n * 256 + r) * LD0 + C_MK + hd_]);
        KMEAN[idx] = f2bf(s * (1.f / 256.f));
        continue;
      }
      const int var = it >> 4, mt = it & 15;
      const int isv = var >> 1, g = var & 1;
      const int m0 = mt * 64;
      const int coff = (isv ? C_VCI : C_KCI) + g * 64;
      const bf16_t* W1T = (const bf16_t*)(ws + (isv ? OFF_W1VT : OFF_W1KT));
      const bf16_t* W2T = (const bf16_t*)(ws + (isv ? OFF_W2VT : OFF_W2KT));
      auto la = [&](int kt, int row, int ch) -> uint4 {
        const int n = m0 + row;
        if (n > 1022) return make_uint4(0, 0, 0, 0);
        return *(const uint4*)(PR0 + (size_t)(16 * n + (kt >> 1)) * LD0 + coff + (kt & 1) * 32 + ch * 8);
      };
      auto lb = [&](int kt, int row, int ch) { return ld_bf(W1T, 2048, row, kt, ch); };
      f32x4 acc[2][2]; zero_acc(acc);
      gemm_tile<2, 2, true>(acc, 64, la, lb, smem);
      bf16_t* hid = HID + (size_t)var * 1024 * 64;
#pragma unroll
      for (int i = 0; i < 2; i++)
#pragma unroll
        for (int jj = 0; jj < 2; jj++) {
          const int m = m0 + wm * 32 + i * 16 + r16, n = wn * 32 + jj * 16 + quad * 4;
          f32x4 v = acc[i][jj];
#pragma unroll
          for (int r = 0; r < 4; r++) v[r] = silu_f(v[r] + CB[isv * 64 + n + r]);
          *(uint2*)(hid + (size_t)m * 64 + n) = pack4(v);
        }
      __threadfence_block();
      __syncthreads();
      auto la2 = [&](int kt, int row, int ch) { return ld_bf(hid, 64, m0 + row, kt, ch); };
      auto lb2 = [&](int kt, int row, int ch) { return ld_bf(W2T, 64, row, kt, ch); };
      f32x4 acc2[2][2]; zero_acc(acc2);
      if (!isv) {
        gemm_tile<2, 2, true>(acc2, 2, la2, lb2, smem);
        bf16_t* KC = (bf16_t*)(ws + OFF_KC);
#pragma unroll
        for (int i = 0; i < 2; i++)
#pragma unroll
          for (int jj = 0; jj < 2; jj++) {
            const int m = m0 + wm * 32 + i * 16 + r16, n = wn * 32 + jj * 16 + quad * 4;
            *(uint2*)(KC + (size_t)m * 128 + g * 64 + n) = pack4(acc2[i][jj]);
          }
      } else {
        gemm_tile<2, 2, false>(acc2, 2, la2, lb2, smem);
        bf16_t* VCT = (bf16_t*)(ws + OFF_VCT);
#pragma unroll
        for (int i = 0; i < 2; i++)
#pragma unroll
          for (int jj = 0; jj < 2; jj++) {
            const int m = m0 + wm * 32 + i * 16 + quad * 4, n = wn * 32 + jj * 16 + r16;
            *(uint2*)(VCT + (size_t)(g * 64 + n) * 1024 + m) = pack4(acc2[i][jj]);
          }
      }
    }
  }
  grid.sync();

  {
    const bf16_t* PR0 = (const bf16_t*)(ws + OFF_PR0);
    float* impw = (float*)smem_raw + wave * 1024;
    unsigned* selw = (unsigned*)(smem_raw + 16384) + wave * 32;
    const int N_NSA = 4096 * 2, N_MOBA = 1024 * 8, N_MEM = 1024 * 4;
    for (int it = gw; it < N_NSA + N_MOBA + N_MEM; it += nw) {
      if (it < N_NSA) {
        const int qt = it >> 1, g = it & 1;
        nsa_item(PR0, (const bf16_t*)(ws + OFF_KC), (const bf16_t*)(ws + OFF_VCT), (const bf16_t*)(ws + OFF_VST),
                 (const bf16_t*)(ws + OFF_VWT), (const float*)(ws + OFF_NG), dO, qt * 4, g, impw, selw, lane);
      } else if (it < N_NSA + N_MOBA) {
        const int j = it - N_NSA;
        moba_item(PR0, (const bf16_t*)(ws + OFF_MVT), (const bf16_t*)(ws + OFF_KMEAN), dO, (j >> 3) * 16, j & 7, lane);
      } else {
        const int j = it - N_NSA - N_MOBA;
        mem_attn_item(PR0 + C_EQ, LD0, PR0 + C_EZ, LD0, dO + 1024, 1280, MEMK0, MEMVT0, (j >> 2) * 16, j & 3, lane);
      }
    }
  }
  grid.sync();

  {
    const bf16_t* WO = (const bf16_t*)(ws + OFF_WOUT0T);
    for (int it = bid; it < 128 * 8; it += nb) {
      const int tn = it & 7, tm = it >> 3;
      const int m0 = tm * 128, n0 = tn * 128;
      auto la = [&](int kt, int row, int ch) { return ld_bf(dO, 1280, m0 + row, kt, ch); };
      auto lb = [&](int kt, int row, int ch) { return ld_bf(WO, 1280, n0 + row, kt, ch); };
      f32x4 acc[4][4]; zero_acc(acc);
      gemm_tile<4, 4, true>(acc, 40, la, lb, smem);
#pragma unroll
      for (int i = 0; i < 4; i++)
#pragma unroll
        for (int jj = 0; jj < 4; jj++) {
          const int m = m0 + wm * 64 + i * 16 + r16, n = n0 + wn * 64 + jj * 16 + quad * 4;
          *(uint2*)(Y0 + (size_t)m * 1024 + n) = pack4(acc[i][jj]);
        }
    }
  }
  grid.sync();
#else
  {
    for (int i = gtid; i < T * 1024 / 8; i += nthr) ((uint4*)Y0)[i] = make_uint4(0, 0, 0, 0);
    for (int it = bid; it < 8; it += nb) {
      const int tm = (it >> 2) & 1, tn = it & 3;
      const int m0 = tm * 128, n0 = tn * 128;
      auto la = [&](int kt, int row, int ch) { return ld_bf(MEMN, 1024, m0 + row, kt, ch); };
      auto lb = [&](int kt, int row, int ch) { return ld_bf(WMEM1T, 1024, n0 + row, kt, ch); };
      f32x4 acc[4][4]; zero_acc(acc);
      if (n0 < 256) {
        gemm_tile<4, 4, true>(acc, 32, la, lb, smem);
#pragma unroll
        for (int i = 0; i < 4; i++)
#pragma unroll
          for (int jj = 0; jj < 4; jj++) {
            const int m = m0 + wm * 64 + i * 16 + r16, n = n0 + wn * 64 + jj * 16 + quad * 4;
            *(uint2*)(MEMK1 + (size_t)m * 256 + n) = pack4(acc[i][jj]);
          }
      } else {
        gemm_tile<4, 4, false>(acc, 32, la, lb, smem);
#pragma unroll
        for (int i = 0; i < 4; i++)
#pragma unroll
          for (int jj = 0; jj < 4; jj++) {
            const int m = m0 + wm * 64 + i * 16 + quad * 4, n = n0 + wn * 64 + jj * 16 + r16 - 256;
            *(uint2*)(MEMVT1 + (size_t)n * 256 + m) = pack4(acc[i][jj]);
          }
      }
    }
  }
  grid.sync();
#endif

  {
    row_rstd(p.x, Y0, RSTD1, T, gw, nw, lane);
    auto perm = [](int x) { const int h = x >> 8, r = x & 255; return h * 256 + ((r >> 5) & 1) * 128 + (r >> 6) * 32 + (r & 31); };
    transpose_w(p.l1_win, 1024, 6656, (bf16_t*)(ws + OFF_WT1), 4608,
                [&](int n) { return n < 1024 ? perm(n) : (n < 2048 ? 1024 + perm(n - 1024) : (n < 4096 ? n : n + 2048)); },
                (float*)smem_raw, bid, nb);
    transpose_w(p.l1_win, 1024, 6656, (bf16_t*)(ws + OFF_WRZT), 2048, [](int n) { return 4096 + n; }, (float*)smem_raw, bid, nb);
    transpose_w(p.l1_wout, 2304, 1024, (bf16_t*)(ws + OFF_WOUT1T), 1024, [](int n) { return n; }, (float*)smem_raw, bid, nb);
    float* RC = (float*)(ws + OFF_ROPE1C); float* RS = (float*)(ws + OFF_ROPE1S);
    for (int i = gtid; i < T * 128; i += nthr) {
      const int t = i >> 7, d = i & 127;
      const double inv = exp2(-(double)d / 127.0 * 13.287712379549449);
      const double ang = (double)p.pos[t] * inv;
      RC[i] = (float)cos(ang); RS[i] = (float)sin(ang);
    }
  }
  grid.sync();

  bf16_t* Q1 = dO;
  bf16_t* P1 = (bf16_t*)((char*)p.out + DOFF_P);
  bf16_t* KP = (bf16_t*)(ws + OFF_KP);
  bf16_t* KPT = (bf16_t*)(ws + OFF_KPT);
  bf16_t* VT = (bf16_t*)(ws + OFF_VT);
  bf16_t* S1 = (bf16_t*)(ws + OFF_S);
  bf16_t* EQ1 = (bf16_t*)(ws + OFF_EQ1);
  bf16_t* EZ1 = (bf16_t*)(ws + OFF_EZ1);
  bf16_t* O1 = (bf16_t*)(ws + OFF_O);
  bf16_t* Z1 = (bf16_t*)(ws + OFF_Z);

  {
    const bf16_t* WT1 = (const bf16_t*)(ws + OFF_WT1);
    const float* RC = (const float*)(ws + OFF_ROPE1C); const float* RS = (const float*)(ws + OFF_ROPE1S);
    for (int it = bid; it < 128 * 36; it += nb) {
      const int tn = it % 36, tm = it / 36;
      const int m0 = tm * 128, n0 = tn * 128;
      auto la = [&](int kt, int row, int ch) { return ld_norm(p.x, Y0, RSTD1, p.l1_g, m0 + row, kt, ch); };
      auto lb = [&](int kt, int row, int ch) { return ld_bf(WT1, 1024, n0 + row, kt, ch); };
      f32x4 acc[4][4]; zero_acc(acc);
      if (n0 >= 2048 && n0 < 4096) {
        gemm_tile<4, 4, false>(acc, 32, la, lb, smem);
#pragma unroll
        for (int i = 0; i < 4; i++)
#pragma unroll
          for (int jj = 0; jj < 4; jj++) {
            const int m = m0 + wm * 64 + i * 16 + quad * 4, n = n0 + wn * 64 + jj * 16 + r16 - 2048;
            *(uint2*)(VT + (size_t)n * T + m) = pack4(acc[i][jj]);
          }
      } else {
        gemm_tile<4, 4, true>(acc, 32, la, lb, smem);
        const int nbw = n0 + wn * 64;
#pragma unroll
        for (int i = 0; i < 4; i++) {
          const int t = m0 + wm * 64 + i * 16 + r16;
          if (nbw < 2048) {
            const int cgrp = (nbw & 255) >> 6;
#pragma unroll
            for (int jj = 0; jj < 2; jj++) {
              const int d0 = cgrp * 32 + jj * 16 + quad * 4;
              const f32x4 cc = *(const f32x4*)(RC + t * 128 + d0);
              const f32x4 ssn = *(const f32x4*)(RS + t * 128 + d0);
              f32x4 x1 = acc[i][jj], x2 = acc[i][jj + 2];
#pragma unroll
              for (int r = 0; r < 4; r++) {
                acc[i][jj][r] = x1[r] * cc[r] - x2[r] * ssn[r];
                acc[i][jj + 2][r] = x1[r] * ssn[r] + x2[r] * cc[r];
              }
            }
            if (nbw < 1024) {
#pragma unroll
              for (int jj = 0; jj < 4; jj++)
                *(uint2*)(Q1 + (size_t)t * 1024 + nbw + jj * 16 + quad * 4) = pack4(acc[i][jj]);
            } else {
              const int h = (nbw - 1024) >> 8;
              const float lg = log2f(1.f - exp2f(-5.f - (float)h));
              const float ksc = 0.0625f * exp2f(-(float)((t & 255) + 1) * lg);
#pragma unroll
              for (int jj = 0; jj < 4; jj++) {
                f32x4 v = acc[i][jj];
                v[0] *= ksc; v[1] *= ksc; v[2] *= ksc; v[3] *= ksc;
                const int n = nbw - 1024 + jj * 16 + quad * 4;
                *(uint2*)(KP + (size_t)t * 1024 + n) = pack4(v);
#pragma unroll
                for (int r = 0; r < 4; r++) KPT[(size_t)(n + r) * T + t] = f2bf(v[r]);
              }
            }
          } else if (nbw < 4352) {
#pragma unroll
            for (int jj = 0; jj < 4; jj++) {
              f32x4 v = acc[i][jj];
              v[0] *= QSCALE; v[1] *= QSCALE; v[2] *= QSCALE; v[3] *= QSCALE;
              *(uint2*)(EQ1 + (size_t)t * 256 + nbw - 4096 + jj * 16 + quad * 4) = pack4(v);
            }
          } else {
#pragma unroll
            for (int jj = 0; jj < 4; jj++) {
              f32x4 v = acc[i][jj];
              v[0] = silu_f(v[0]); v[1] = silu_f(v[1]); v[2] = silu_f(v[2]); v[3] = silu_f(v[3]);
              *(uint2*)(EZ1 + (size_t)t * 256 + nbw - 4352 + jj * 16 + quad * 4) = pack4(v);
            }
          }
        }
      }
    }
  }
  grid.sync();

  {
    const bool dedicated = nb >= 256;
    for (int it = bid; it < 128; it += nb) {
      const int h = it >> 5, dvt = (it >> 2) & 7, dkt = it & 3;
      const float gL = exp2f(256.f * log2f(1.f - exp2f(-5.f - (float)h)));
      const bf16_t* Ab = VT + (size_t)(h * 512 + dvt * 64) * T;
      const bf16_t* Bb = KPT + (size_t)(h * 256 + dkt * 64) * T;
      f32x4 acc[2][2]; zero_acc(acc);
      for (int c = 0; c < 64; c++) {
        bf16_t* Sd = S1 + ((size_t)(h * 64 + c) * 512 + dvt * 64) * 256 + dkt * 64;
#pragma unroll
        for (int i = 0; i < 2; i++)
#pragma unroll
          for (int jj = 0; jj < 2; jj++) {
            const int m = wm * 32 + i * 16 + r16, n = wn * 32 + jj * 16 + quad * 4;
            *(uint2*)(Sd + (size_t)m * 256 + n) = pack4(acc[i][jj]);
          }
        if (c == 63) break;
        auto la = [&](int kt, int row, int ch) { return ld_bf(Ab + c * 256, T, row, kt, ch); };
        auto lb = [&](int kt, int row, int ch) { return ld_bf(Bb + c * 256, T, row, kt, ch); };
        gemm_tile<2, 2, true>(acc, 8, la, lb, smem);
#pragma unroll
        for (int i = 0; i < 2; i++)
#pragma unroll
          for (int jj = 0; jj < 2; jj++) { acc[i][jj][0] *= gL; acc[i][jj][1] *= gL; acc[i][jj][2] *= gL; acc[i][jj][3] *= gL; }
      }
    }
    const int ob = dedicated ? bid - 128 : bid, onb = dedicated ? nb - 128 : nb;
    if (ob >= 0) {
      for (int it = ob; it < 1024 + 1024; it += onb) {
        if (it < 1024) {
          const int h = it >> 8, c = (it >> 2) & 63, tm = (it >> 1) & 1, tn = it & 1;
          const int m0 = c * 256 + tm * 128, n0 = c * 256 + tn * 128;
          auto la = [&](int kt, int row, int ch) { return ld_bf(Q1 + h * 256, 1024, m0 + row, kt, ch); };
          auto lb = [&](int kt, int row, int ch) { return ld_bf(KP + h * 256, 1024, n0 + row, kt, ch); };
          f32x4 acc[4][4]; zero_acc(acc);
          if (tn <= tm) gemm_tile<4, 4, true>(acc, 8, la, lb, smem);
#pragma unroll
          for (int i = 0; i < 4; i++)
#pragma unroll
            for (int jj = 0; jj < 4; jj++) {
              const int m = m0 + wm * 64 + i * 16 + r16, n = n0 + wn * 64 + jj * 16 + quad * 4;
              f32x4 v = acc[i][jj];
#pragma unroll
              for (int r = 0; r < 4; r++) if (n + r > m) v[r] = 0.f;
              *(uint2*)(P1 + ((size_t)h * T + m) * 256 + (n - c * 256)) = pack4(v);
            }
        } else {
          const int j = (it - 1024) * 4 + wave;
          mem_attn_item(EQ1, 256, EZ1, 256, EQ1, 256, MEMK1, MEMVT1, (j >> 2) * 16, j & 3, lane);
        }
      }
    }
  }
  grid.sync();

  {
    for (int it = bid; it < 2048; it += nb) {
      const int h = it >> 9, c = (it >> 3) & 63, tm = (it >> 2) & 1, tn = it & 3;
      const int m0 = c * 256 + tm * 128, n0 = tn * 128;
      const bf16_t* Sb = S1 + ((size_t)(h * 64 + c) * 512 + n0) * 256;
      const bf16_t* Pb = P1 + ((size_t)h * T + m0) * 256;
      const bf16_t* Vb = VT + (size_t)(h * 512 + n0) * T + c * 256;
      auto la = [&](int kt, int row, int ch) {
        return kt < 8 ? ld_bf(Q1 + h * 256, 1024, m0 + row, kt, ch) : ld_bf(Pb, 256, row, kt - 8, ch);
      };
      auto lb = [&](int kt, int row, int ch) {
        return kt < 8 ? ld_bf(Sb, 256, row, kt, ch) : ld_bf(Vb, T, row, kt - 8, ch);
      };
      f32x4 acc[4][4]; zero_acc(acc);
      gemm_tile<4, 4, true>(acc, 16, la, lb, smem);
      const float lg = log2f(1.f - exp2f(-5.f - (float)h));
#pragma unroll
      for (int i = 0; i < 4; i++) {
        const int t = m0 + wm * 64 + i * 16 + r16;
        const float qd = exp2f((float)((t & 255) + 1) * lg);
#pragma unroll
        for (int jj = 0; jj < 4; jj++) {
          f32x4 v = acc[i][jj];
          v[0] *= qd; v[1] *= qd; v[2] *= qd; v[3] *= qd;
          *(uint2*)(O1 + (size_t)t * 2048 + h * 512 + n0 + wn * 64 + jj * 16 + quad * 4) = pack4(v);
        }
      }
    }
  }
  grid.sync();

  {
    const bf16_t* WRZT = (const bf16_t*)(ws + OFF_WRZT);
    for (int it = bid; it < 128 * 16; it += nb) {
      const int tn = it & 15, tm = it >> 4;
      const int m0 = tm * 128, n0 = tn * 128;
      auto la = [&](int kt, int row, int ch) { return ld_norm(p.x, Y0, RSTD1, p.l1_g, m0 + row, kt, ch); };
      auto lb = [&](int kt, int row, int ch) { return ld_bf(WRZT, 1024, n0 + row, kt, ch); };
      f32x4 acc[4][4]; zero_acc(acc);
      gemm_tile<4, 4, true>(acc, 32, la, lb, smem);
#pragma unroll
      for (int i = 0; i < 4; i++)
#pragma unroll
        for (int jj = 0; jj < 4; jj++) {
          const int m = m0 + wm * 64 + i * 16 + r16, n = n0 + wn * 64 + jj * 16 + quad * 4;
          f32x4 v = acc[i][jj];
          v[0] = silu_f(v[0]); v[1] = silu_f(v[1]); v[2] = silu_f(v[2]); v[3] = silu_f(v[3]);
          *(uint2*)(Z1 + (size_t)m * 2048 + n) = pack4(v);
        }
    }
  }
  grid.sync();

  {
    for (int it = gw; it < T * 4; it += nw) {
      const size_t off = (size_t)it * 512 + lane * 8;
      uint4 ov = *(const uint4*)(O1 + off);
      uint4 zv = *(const uint4*)(Z1 + off);
      float o[8] = {bflo(ov.x), bfhi(ov.x), bflo(ov.y), bfhi(ov.y), bflo(ov.z), bfhi(ov.z), bflo(ov.w), bfhi(ov.w)};
      float z[8] = {bflo(zv.x), bfhi(zv.x), bflo(zv.y), bfhi(zv.y), bflo(zv.z), bfhi(zv.z), bflo(zv.w), bfhi(zv.w)};
      float s = 0.f;
#pragma unroll
      for (int i = 0; i < 8; i++) s += o[i];
#pragma unroll
      for (int k = 32; k > 0; k >>= 1) s += __shfl_xor(s, k);
      const float mu = s * (1.f / 512.f);
      float v = 0.f;
#pragma unroll
      for (int i = 0; i < 8; i++) { o[i] -= mu; v += o[i] * o[i]; }
#pragma unroll
      for (int k = 32; k > 0; k >>= 1) v += __shfl_xor(v, k);
      const float rs = rsqrtf(v * (1.f / 512.f) + 1e-6f);
      uint4 r;
      r.x = pack2(o[0] * rs * z[0], o[1] * rs * z[1]); r.y = pack2(o[2] * rs * z[2], o[3] * rs * z[3]);
      r.z = pack2(o[4] * rs * z[4], o[5] * rs * z[5]); r.w = pack2(o[6] * rs * z[6], o[7] * rs * z[7]);
      *(uint4*)(Z1 + off) = r;
    }
  }
  grid.sync();

  {
    const bf16_t* WO = (const bf16_t*)(ws + OFF_WOUT1T);
    for (int it = bid; it < 128 * 8; it += nb) {
      const int tn = it & 7, tm = it >> 3;
      const int m0 = tm * 128, n0 = tn * 128;
      auto la = [&](int kt, int row, int ch) {
        return kt < 64 ? ld_bf(Z1, 2048, m0 + row, kt, ch) : ld_bf(EQ1, 256, m0 + row, kt - 64, ch);
      };
      auto lb = [&](int kt, int row, int ch) { return ld_bf(WO, 2304, n0 + row, kt, ch); };
      f32x4 acc[4][4]; zero_acc(acc);
      gemm_tile<4, 4, true>(acc, 72, la, lb, smem);
#pragma unroll
      for (int i = 0; i < 4; i++)
#pragma unroll
        for (int jj = 0; jj < 4; jj++) {
          const int m = m0 + wm * 64 + i * 16 + r16, n = n0 + wn * 64 + jj * 16 + quad * 4;
          const float4 xv = *(const float4*)(p.x + (size_t)m * 1024 + n);
          const uint2 yv = *(const uint2*)(Y0 + (size_t)m * 1024 + n);
          float4 r;
          r.x = xv.x + bflo(yv.x) + acc[i][jj][0]; r.y = xv.y + bfhi(yv.x) + acc[i][jj][1];
          r.z = xv.z + bflo(yv.y) + acc[i][jj][2]; r.w = xv.w + bfhi(yv.y) + acc[i][jj][3];
          *(float4*)(p.out + (size_t)m * 1024 + n) = r;
        }
    }
  }
  grid.sync();

  {
    for (int t = gw; t < T; t += nw) {
      float4* xp = (float4*)(p.out + (size_t)t * 1024);
      float4 v[4]; float s = 0.f;
#pragma unroll
      for (int i = 0; i < 4; i++) { v[i] = xp[lane + i * 64]; s += v[i].x * v[i].x + v[i].y * v[i].y + v[i].z * v[i].z + v[i].w * v[i].w; }
#pragma unroll
      for (int o = 32; o > 0; o >>= 1) s += __shfl_xor(s, o);
      const float rs = rsqrtf(s * (1.f / 1024.f) + 1e-6f);
#pragma unroll
      for (int i = 0; i < 4; i++) {
        const float4 gg = ((const float4*)p.fin_g)[lane + i * 64];
        v[i].x *= rs * gg.x; v[i].y *= rs * gg.y; v[i].z *= rs * gg.z; v[i].w *= rs * gg.w;
        xp[lane + i * 64] = v[i];
      }
    }
  }
}

extern "C" void kernel_launch(void* const* d_in, const int* in_sizes, int n_in,
                              void* d_out, int out_size, void* d_ws, size_t ws_size,
                              hipStream_t stream) {
  static int grid_blocks = 0;
  if (!grid_blocks) {
    int dev = 0, cus = 0, per_cu = 0;
    (void)hipGetDevice(&dev);
    (void)hipDeviceGetAttribute(&cus, hipDeviceAttributeMultiprocessorCount, dev);
    (void)hipOccupancyMaxActiveBlocksPerMultiprocessor(&per_cu, fwd_megakernel, 256, 0);
    if (per_cu < 1) per_cu = 1;
    if (per_cu > 2) per_cu = 2;
    grid_blocks = cus * per_cu;
  }
  Params p{};
  p.x = (const float*)d_in[0]; p.mem = (const float*)d_in[1]; p.pos = (const int*)d_in[2];
  p.l0_g = (const float*)d_in[3]; p.l0_win = (const float*)d_in[4]; p.l0_gb = (const float*)d_in[5];
  p.pe_k = (const float*)d_in[6]; p.w1_k = (const float*)d_in[7]; p.w2_k = (const float*)d_in[8];
  p.pe_v = (const float*)d_in[9]; p.w1_v = (const float*)d_in[10]; p.w2_v = (const float*)d_in[11];
  p.l0_wmem = (const float*)d_in[12]; p.l0_wout = (const float*)d_in[13];
  p.l1_g = (const float*)d_in[14]; p.l1_win = (const float*)d_in[15]; p.l1_wmem = (const float*)d_in[16];
  p.l1_wout = (const float*)d_in[17]; p.mem_g = (const float*)d_in[18]; p.fin_g = (const float*)d_in[19];
  p.out = (float*)d_out; p.ws = (char*)d_ws;
  void* args[] = {&p};
  hipError_t e = hipLaunchCooperativeKernel((void*)fwd_megakernel, dim3(grid_blocks), dim3(256), args, 0, stream);
  if (e != hipSuccess) fprintf(stderr, "cooperative launch failed: %s (grid %d)\n", hipGetErrorString(e), grid_blocks);
}
```

```cpp
#include <hip/hip_runtime.h>
#include <hip/hip_cooperative_groups.h>
#include <cstdio>
namespace cg = cooperative_groups;

typedef unsigned short bf16_t;
typedef __attribute__((ext_vector_type(8))) short bf16x8;
typedef __attribute__((ext_vector_type(4))) short s16x4;
typedef __attribute__((ext_vector_type(4))) float f32x4;
#define DI __device__ __forceinline__
#define MFMA16(a, b, c) __builtin_amdgcn_mfma_f32_16x16x32_bf16((a), (b), (c), 0, 0, 0)

#ifndef DO_L0
#define DO_L0 1
#endif
#ifndef TSA_MASK
#define TSA_MASK 0
#endif
#ifndef TSB_MASK
#define TSB_MASK 0
#endif
#define TSTAMP(k) do { if ((TSA_MASK | TSB_MASK) && blockIdx.x == 0 && threadIdx.x == 0) TS[k] = wall_clock64(); } while (0)

constexpr int T = 16384;
constexpr int TP = 16384 + 64;
constexpr int LD0 = 4480;
constexpr int C_NQ = 0, C_KCI = 512, C_VCI = 640, C_KS = 768, C_VS = 896, C_KW = 1024, C_VW = 1152, C_NZ = 1280,
              C_MQ = 1792, C_MK = 2304, C_MV = 2816, C_MZ = 3328, C_EQ = 3840, C_EZ = 4096, C_NG = 4352;
constexpr float QSCALE = 0.125f * 1.4426950408889634f;
constexpr size_t Mi = 1048576;
constexpr size_t OFF_Y0 = 0;
constexpr size_t OFF_RSTD0 = 32 * Mi;
constexpr size_t OFF_RSTD1 = OFF_RSTD0 + 65536;
constexpr size_t OFF_MEMN = OFF_RSTD1 + 65536;
constexpr size_t OFF_MEMK0 = OFF_MEMN + 524288;
constexpr size_t OFF_MEMVT0 = OFF_MEMK0 + 131072;
constexpr size_t OFF_MEMK1 = OFF_MEMVT0 + 131072;
constexpr size_t OFF_MEMVT1 = OFF_MEMK1 + 131072;
constexpr size_t OFF_WMEM0T = 33 * Mi + 512 * 1024;
constexpr size_t OFF_WMEM1T = OFF_WMEM0T + Mi;
constexpr size_t RG = 36 * Mi;
constexpr size_t OFF_WT0 = RG;
constexpr size_t OFF_WOUT0T = RG + 9 * Mi;
constexpr size_t OFF_W1KT = RG + 12 * Mi;
constexpr size_t OFF_W1VT = OFF_W1KT + 262144;
constexpr size_t OFF_W2KT = OFF_W1VT + 262144;
constexpr size_t OFF_W2VT = OFF_W2KT + 8192;
constexpr size_t OFF_CBIAS = OFF_W2VT + 8192;
constexpr size_t OFF_KMEAN = OFF_CBIAS + 1024;
constexpr size_t OFF_KC = RG + 13 * Mi;
constexpr size_t OFF_VCT = OFF_KC + 262144;
constexpr size_t OFF_HID = OFF_VCT + 262144;
constexpr size_t OFF_ROPE0C = RG + 14 * Mi;
constexpr size_t OFF_ROPE0S = RG + 16 * Mi;
constexpr size_t OFF_NG = RG + 18 * Mi;
constexpr size_t OFF_VST = RG + 20 * Mi;
constexpr size_t OFF_VWT = RG + 25 * Mi;
constexpr size_t OFF_MVT = RG + 30 * Mi;
constexpr size_t OFF_PR0 = RG + 47 * Mi;
constexpr size_t OFF_WRZT = RG;
constexpr size_t OFF_WOUT1T = RG + 4 * Mi;
constexpr size_t OFF_EQ1 = RG + 9 * Mi;
constexpr size_t OFF_EZ1 = RG + 17 * Mi;
constexpr size_t OFF_KP = RG + 25 * Mi;
constexpr size_t OFF_KPT = RG + 57 * Mi;
constexpr size_t OFF_O = OFF_KP;
constexpr size_t OFF_VT = RG + 89 * Mi + 512 * 1024;
constexpr size_t OFF_Z = OFF_VT;
constexpr size_t OFF_S = RG + 154 * Mi + 512 * 1024;
constexpr size_t OFF_ROPE1C = OFF_S;
constexpr size_t OFF_ROPE1S = OFF_S + 8 * Mi;
constexpr size_t OFF_WT1 = OFF_S + 16 * Mi;
constexpr size_t OFF_XB1 = OFF_S + 25 * Mi;
constexpr size_t OFF_XB0 = 0;
constexpr size_t OFF_PARTA = 223 * Mi;
constexpr size_t OFF_PARTB = 0;
constexpr size_t PART_HEAD = 6 * Mi;
constexpr size_t OFF_LSESEL = 253 * Mi;
constexpr size_t OFF_LSEOWN = 253 * Mi + 1536 * 1024;
constexpr size_t OFF_CNT = 33 * Mi + 262144 + 1024;
constexpr size_t OFF_XBAR = 33 * Mi + 262144 + 16384;
constexpr size_t DOFF_BUCKET = 40 * Mi;
constexpr int BUCKET_HEAD = 516096;
constexpr size_t DOFF_P = 32 * Mi;

struct Params {
  const float* x; const float* mem; const int* pos;
  const float *l0_g, *l0_win, *l0_gb, *pe_k, *w1_k, *w2_k, *pe_v, *w1_v, *w2_v, *l0_wmem, *l0_wout;
  const float *l1_g, *l1_win, *l1_wmem, *l1_wout, *mem_g, *fin_g;
  float* out; char* ws;
};

DI bf16_t f2bf(float f) { unsigned u = __float_as_uint(f); u += 0x7fffu + ((u >> 16) & 1u); return (bf16_t)(u >> 16); }
DI float bf2f(bf16_t h) { return __uint_as_float(((unsigned)h) << 16); }
typedef __bf16 bf2_t __attribute__((ext_vector_type(2)));
typedef float f2_t __attribute__((ext_vector_type(2)));
DI unsigned pack2(float a, float b) { f2_t v = {a, b}; bf2_t r = __builtin_convertvector(v, bf2_t); return __builtin_bit_cast(unsigned, r); }
DI float bflo(unsigned u) { return __uint_as_float(u << 16); }
DI float bfhi(unsigned u) { return __uint_as_float(u & 0xffff0000u); }
DI float silu_f(float x) { return x / (1.f + __expf(-x)); }
DI float sigm_f(float x) { return 1.f / (1.f + __expf(-x)); }
DI float ex2(float x) { return __builtin_amdgcn_exp2f(x); }
DI void wave_lds_sync() { asm volatile("s_waitcnt lgkmcnt(0)" ::: "memory"); }
DI uint2 pack4(f32x4 v) { uint2 r; r.x = pack2(v[0], v[1]); r.y = pack2(v[2], v[3]); return r; }

template <int WM, int WN, bool SWAP, class LA, class LB>
DI void gemm_tile(f32x4 (&acc)[WM][WN], int nk, LA loadA, LB loadB, bf16_t* smem) {
  constexpr int BM = WM * 32, BN = WN * 32, LD = 80, NA = BM / 32, NB = BN / 32;
  bf16_t* sA = smem;
  bf16_t* sB = smem + 2 * BM * LD;
  int tid = threadIdx.x;
  asm volatile("" : "+v"(tid));
  const int lane = tid & 63, wave = tid >> 6, wm = wave >> 1, wn = wave & 1;
  const int r16 = lane & 15, quad = lane >> 4;
  uint4 ra0[NA], rb0[NB], ra1[NA], rb1[NB];
#define GT_LOAD(RA, RB, KT)                                                                          \
  {                                                                                                  \
    _Pragma("unroll") for (int i = 0; i < NA; i++) { int idx = tid + i * 256; RA[i] = loadA((KT), idx >> 3, idx & 7); } \
    _Pragma("unroll") for (int i = 0; i < NB; i++) { int idx = tid + i * 256; RB[i] = loadB((KT), idx >> 3, idx & 7); } \
    __builtin_amdgcn_sched_barrier(0);                                                               \
  }
#define GT_STORE(RA, RB, BUF)                                                                        \
  {                                                                                                  \
    __builtin_amdgcn_sched_barrier(0);                                                               \
    bf16_t* sAn = sA + (BUF) * BM * LD; bf16_t* sBn = sB + (BUF) * BN * LD;                           \
    _Pragma("unroll") for (int i = 0; i < NA; i++) { int idx = tid + i * 256; *(uint4*)(sAn + (idx >> 3) * LD + (idx & 7) * 8) = RA[i]; } \
    _Pragma("unroll") for (int i = 0; i < NB; i++) { int idx = tid + i * 256; *(uint4*)(sBn + (idx >> 3) * LD + (idx & 7) * 8) = RB[i]; } \
  }
#define GT_COMPUTE(BUF)                                                                              \
  {                                                                                                  \
    const bf16_t* ab = sA + (BUF) * BM * LD + (wm * WM * 16 + r16) * LD + quad * 8;                   \
    const bf16_t* bb = sB + (BUF) * BN * LD + (wn * WN * 16 + r16) * LD + quad * 8;                   \
    _Pragma("unroll") for (int kk = 0; kk < 2; kk++) {                                               \
      bf16x8 af[WM], bfr[WN];                                                                        \
      _Pragma("unroll") for (int i = 0; i < WM; i++) af[i] = *(const bf16x8*)(ab + i * 16 * LD + kk * 32);  \
      _Pragma("unroll") for (int j = 0; j < WN; j++) bfr[j] = *(const bf16x8*)(bb + j * 16 * LD + kk * 32); \
      _Pragma("unroll") for (int i = 0; i < WM; i++)                                                 \
        _Pragma("unroll") for (int j = 0; j < WN; j++)                                               \
          acc[i][j] = SWAP ? MFMA16(bfr[j], af[i], acc[i][j]) : MFMA16(af[i], bfr[j], acc[i][j]);    \
    }                                                                                                \
  }
  GT_LOAD(ra0, rb0, 0);
  if (nk > 1) GT_LOAD(ra1, rb1, 1);
  GT_STORE(ra0, rb0, 0);
  __syncthreads();
  for (int kt = 0; kt < nk; kt += 2) {
    if (kt + 2 < nk) GT_LOAD(ra0, rb0, kt + 2);
    GT_COMPUTE(0);
    if (kt + 1 < nk) GT_STORE(ra1, rb1, 1);
    __syncthreads();
    if (kt + 1 >= nk) break;
    if (kt + 3 < nk) GT_LOAD(ra1, rb1, kt + 3);
    GT_COMPUTE(1);
    if (kt + 2 < nk) GT_STORE(ra0, rb0, 0);
    __syncthreads();
  }
#undef GT_LOAD
#undef GT_STORE
#undef GT_COMPUTE
}

template <int WM, int WN>
DI void zero_acc(f32x4 (&acc)[WM][WN]) {
#pragma unroll
  for (int i = 0; i < WM; i++)
#pragma unroll
    for (int j = 0; j < WN; j++) acc[i][j] = (f32x4){0.f, 0.f, 0.f, 0.f};
}

DI uint4 ld_bf(const bf16_t* base, size_t ld, int row, int kt, int ch) {
  return *(const uint4*)(base + (size_t)row * ld + kt * 64 + ch * 8);
}
DI uint4 ld_x(const float* x, const bf16_t* y0, int t, int kt, int ch) {
  const int k = kt * 64 + ch * 8;
  const float4* xp = (const float4*)(x + (size_t)t * 1024 + k);
  float4 a = xp[0], b = xp[1];
  if (y0) {
    uint4 yv = *(const uint4*)(y0 + (size_t)t * 1024 + k);
    a.x += bflo(yv.x); a.y += bfhi(yv.x); a.z += bflo(yv.y); a.w += bfhi(yv.y);
    b.x += bflo(yv.z); b.y += bfhi(yv.z); b.z += bflo(yv.w); b.w += bfhi(yv.w);
  }
  uint4 r;
  r.x = pack2(a.x, a.y); r.y = pack2(a.z, a.w); r.z = pack2(b.x, b.y); r.w = pack2(b.z, b.w);
  return r;
}

template <class CM>
DI void transpose_w(const float* src, int K, int srcN, bf16_t* dst, int Npad, CM cm, float* sm, int bid, int nb, const float* gk = nullptr) {
  int tid = threadIdx.x;
  asm volatile("" : "+v"(tid));
  const int tx = tid & 63, ty = tid >> 6;
  const int tilesK = K / 64, tilesN = Npad / 64;
  for (int it = bid; it < tilesK * tilesN; it += nb) {
    const int n0 = (it / tilesK) * 64, k0 = (it % tilesK) * 64;
    const int sc = cm(n0 + tx);
#pragma unroll 4
    for (int i = 0; i < 16; i++) {
      int kk = ty + i * 4;
      sm[kk * 65 + tx] = sc >= 0 ? src[(size_t)(k0 + kk) * srcN + sc] : 0.f;
    }
    __syncthreads();
#pragma unroll 4
    for (int i = 0; i < 16; i++) {
      int nn = ty + i * 4;
      dst[(size_t)(n0 + nn) * K + k0 + tx] = f2bf(sm[tx * 65 + nn] * (gk ? gk[k0 + tx] : 1.f));
    }
    __syncthreads();
  }
}

DI void row_rstd(const float* x, const bf16_t* y0, float* rstd, bf16_t* xb, int rows, int gw, int nw, int lane) {
  for (int t = gw; t < rows; t += nw) {
    const float4* xp = (const float4*)(x + (size_t)t * 1024);
    float s = 0.f;
#pragma unroll
    for (int i = 0; i < 4; i++) {
      float4 v = xp[lane + i * 64];
      if (y0) {
        uint2 yv = *(const uint2*)(y0 + (size_t)t * 1024 + (lane + i * 64) * 4);
        v.x += bflo(yv.x); v.y += bfhi(yv.x); v.z += bflo(yv.y); v.w += bfhi(yv.y);
      }
      s += v.x * v.x + v.y * v.y + v.z * v.z + v.w * v.w;
      uint2 o; o.x = pack2(v.x, v.y); o.y = pack2(v.z, v.w);
      *(uint2*)(xb + (size_t)t * 1024 + (lane + i * 64) * 4) = o;
    }
#pragma unroll
    for (int o = 32; o > 0; o >>= 1) s += __shfl_xor(s, o);
    if (lane == 0) rstd[t] = rsqrtf(s * (1.f / 1024.f) + 1e-6f);
  }
}

struct AttnSt { float m, l; f32x4 o[4]; };
DI void attn_init(AttnSt& s) {
  s.m = -1e30f; s.l = 0.f;
#pragma unroll
  for (int i = 0; i < 4; i++) s.o[i] = (f32x4){0.f, 0.f, 0.f, 0.f};
}
DI f32x4 qk16(const bf16_t* K, int ks, int key0, bf16x8 q0, bf16x8 q1, int lane) {
  const bf16_t* kp = K + (size_t)(key0 + (lane & 15)) * ks + (lane >> 4) * 8;
  bf16x8 k0 = *(const bf16x8*)kp;
  bf16x8 k1 = *(const bf16x8*)(kp + 32);
  f32x4 s = {0.f, 0.f, 0.f, 0.f};
  s = MFMA16(k0, q0, s);
  s = MFMA16(k1, q1, s);
  return s;
}
DI f32x4 qk16p(const bf16_t* K, int ks, int key0, int half, bf16x8 q0, bf16x8 q1, int lane) {
  const int r16 = lane & 15;
  const bf16_t* kp = K + (size_t)(key0 + (r16 >> 2) * 8 + (r16 & 3) + half * 4) * ks + (lane >> 4) * 8;
  bf16x8 k0 = *(const bf16x8*)kp;
  bf16x8 k1 = *(const bf16x8*)(kp + 32);
  f32x4 s = {0.f, 0.f, 0.f, 0.f};
  s = MFMA16(k0, q0, s);
  s = MFMA16(k1, q1, s);
  return s;
}
template <class MF>
DI void attn_step(const bf16_t* K, int ks, const bf16_t* Vt, int vs, int key0, bf16x8 q0, bf16x8 q1, AttnSt& st,
                  MF maskf, int lane) {
  const int r16 = lane & 15, quad = lane >> 4;
  f32x4 sa = qk16p(K, ks, key0, 0, q0, q1, lane);
  f32x4 sb = qk16p(K, ks, key0, 1, q0, q1, lane);
  const bf16_t* vp = Vt + (size_t)r16 * vs + key0 + quad * 8;
  bf16x8 vf[4];
#pragma unroll
  for (int dt = 0; dt < 4; dt++) vf[dt] = *(const bf16x8*)(vp + (size_t)dt * 16 * vs);
  bool ma[4], mb[4];
  float lm = -1e30f;
#pragma unroll
  for (int r = 0; r < 4; r++) {
    ma[r] = maskf(key0 + quad * 8 + r);
    mb[r] = maskf(key0 + quad * 8 + 4 + r);
    if (ma[r]) lm = fmaxf(lm, sa[r]);
    if (mb[r]) lm = fmaxf(lm, sb[r]);
  }
  if (__ballot(lm > st.m + 8.f) != 0ull) {
    float mx = fmaxf(lm, __shfl_xor(lm, 16));
    mx = fmaxf(mx, __shfl_xor(mx, 32));
    const float mn = (mx > st.m + 8.f) ? mx : st.m;
    const float alpha = ex2(st.m - mn);
    st.l *= alpha;
    st.m = mn;
#pragma unroll
    for (int dt = 0; dt < 4; dt++) st.o[dt] *= alpha;
  }
  float pa[4], pb[4], rs = 0.f;
#pragma unroll
  for (int r = 0; r < 4; r++) {
    pa[r] = ma[r] ? ex2(sa[r] - st.m) : 0.f;
    pb[r] = mb[r] ? ex2(sb[r] - st.m) : 0.f;
    rs += pa[r] + pb[r];
  }
  st.l += rs;
  uint4 pu;
  pu.x = pack2(pa[0], pa[1]); pu.y = pack2(pa[2], pa[3]); pu.z = pack2(pb[0], pb[1]); pu.w = pack2(pb[2], pb[3]);
  const bf16x8 pf = __builtin_bit_cast(bf16x8, pu);
#pragma unroll
  for (int dt = 0; dt < 4; dt++) st.o[dt] = MFMA16(vf[dt], pf, st.o[dt]);
}
template <class MF>
DI void attn_compute64(const bf16x8 (&kf)[8], const bf16x8 (&vf)[8], int key0, bf16x8 q0, bf16x8 q1, AttnSt& st, MF maskf, int lane) {
  const int quad = lane >> 4;
  f32x4 sc4[4];
#pragma unroll
  for (int j = 0; j < 4; j++) {
    f32x4 z = {0.f, 0.f, 0.f, 0.f};
    z = MFMA16(kf[(j >> 1) * 4 + (j & 1) * 2 + 0], q0, z);
    sc4[j] = MFMA16(kf[(j >> 1) * 4 + (j & 1) * 2 + 1], q1, z);
  }
  bool mk[4][4];
  float lm = -1e30f;
#pragma unroll
  for (int j = 0; j < 4; j++)
#pragma unroll
    for (int r = 0; r < 4; r++) {
      mk[j][r] = maskf(key0 + (j >> 1) * 32 + quad * 8 + (j & 1) * 4 + r);
      if (mk[j][r]) lm = fmaxf(lm, sc4[j][r]);
    }
  if (__ballot(lm > st.m + 8.f) != 0ull) {
    float mx = fmaxf(lm, __shfl_xor(lm, 16));
    mx = fmaxf(mx, __shfl_xor(mx, 32));
    const float mn = (mx > st.m + 8.f) ? mx : st.m;
    const float alpha = ex2(st.m - mn);
    st.l *= alpha;
    st.m = mn;
#pragma unroll
    for (int dt = 0; dt < 4; dt++) st.o[dt] *= alpha;
  }
  float pv[4][4], rs = 0.f;
#pragma unroll
  for (int j = 0; j < 4; j++)
#pragma unroll
    for (int r = 0; r < 4; r++) { pv[j][r] = mk[j][r] ? ex2(sc4[j][r] - st.m) : 0.f; rs += pv[j][r]; }
  st.l += rs;
#pragma unroll
  for (int hb = 0; hb < 2; hb++) {
    uint4 pu;
    pu.x = pack2(pv[hb * 2][0], pv[hb * 2][1]); pu.y = pack2(pv[hb * 2][2], pv[hb * 2][3]);
    pu.z = pack2(pv[hb * 2 + 1][0], pv[hb * 2 + 1][1]); pu.w = pack2(pv[hb * 2 + 1][2], pv[hb * 2 + 1][3]);
    const bf16x8 pf = __builtin_bit_cast(bf16x8, pu);
#pragma unroll
    for (int dt = 0; dt < 4; dt++) st.o[dt] = MFMA16(vf[hb * 4 + dt], pf, st.o[dt]);
  }
}
template <class MF>
DI void attn_step64(const bf16_t* K, int ks, const bf16_t* Vt, int vs, int key0, bf16x8 q0, bf16x8 q1, AttnSt& st,
                    MF maskf, int lane) {
  const int r16 = lane & 15, quad = lane >> 4;
  const bf16_t* kp = K + (size_t)(key0 + (r16 >> 2) * 8 + (r16 & 3)) * ks + quad * 8;
  bf16x8 kf[8];
#pragma unroll
  for (int hb = 0; hb < 2; hb++) {
    const bf16_t* kq = kp + (size_t)hb * 32 * ks;
    kf[hb * 4 + 0] = *(const bf16x8*)kq; kf[hb * 4 + 1] = *(const bf16x8*)(kq + 32);
    kf[hb * 4 + 2] = *(const bf16x8*)(kq + (size_t)4 * ks); kf[hb * 4 + 3] = *(const bf16x8*)(kq + (size_t)4 * ks + 32);
  }
  const bf16_t* vp = Vt + (size_t)r16 * vs + key0 + quad * 8;
  bf16x8 vf[8];
#pragma unroll
  for (int dt = 0; dt < 4; dt++) { vf[dt] = *(const bf16x8*)(vp + (size_t)dt * 16 * vs); vf[4 + dt] = *(const bf16x8*)(vp + (size_t)dt * 16 * vs + 32); }
  attn_compute64(kf, vf, key0, q0, q1, st, maskf, lane);
}
template <class MF>
DI void attn_block_lds(const bf16_t* K, int ks, const bf16_t* Vt, int vs, int key0, bf16x8 q0, bf16x8 q1, AttnSt& st,
                       MF maskf, char* stage, int lane) {
  const int r16 = lane & 15, quad = lane >> 4;
  const int rsub = lane >> 3, ch = lane & 7;
  {
    uint4 tk[8];
#pragma unroll
    for (int i = 0; i < 8; i++) tk[i] = *(const uint4*)(K + (size_t)(key0 + i * 8 + rsub) * ks + ch * 8);
    uint4 tv[4];
#pragma unroll
    for (int i = 0; i < 4; i++) tv[i] = *(const uint4*)(Vt + (size_t)(i * 8 + rsub) * vs + key0 + ch * 8);
#pragma unroll
    for (int i = 0; i < 8; i++) *(uint4*)(stage + (i * 8 + rsub) * 144 + ch * 16) = tk[i];
#pragma unroll
    for (int i = 0; i < 4; i++) tk[i] = *(const uint4*)(Vt + (size_t)((i + 4) * 8 + rsub) * vs + key0 + ch * 8);
#pragma unroll
    for (int i = 0; i < 4; i++) *(uint4*)(stage + 9216 + (i * 8 + rsub) * 144 + ch * 16) = tv[i];
#pragma unroll
    for (int i = 0; i < 4; i++) *(uint4*)(stage + 9216 + ((i + 4) * 8 + rsub) * 144 + ch * 16) = tk[i];
  }
  wave_lds_sync();
  bf16x8 kf[8], vf[8];
  const char* kb = stage + ((r16 >> 2) * 8 + (r16 & 3)) * 144 + quad * 16;
#pragma unroll
  for (int hb = 0; hb < 2; hb++) {
    kf[hb * 4 + 0] = *(const bf16x8*)(kb + hb * 32 * 144);
    kf[hb * 4 + 1] = *(const bf16x8*)(kb + hb * 32 * 144 + 64);
    kf[hb * 4 + 2] = *(const bf16x8*)(kb + (hb * 32 + 4) * 144);
    kf[hb * 4 + 3] = *(const bf16x8*)(kb + (hb * 32 + 4) * 144 + 64);
  }
  const char* vb = stage + 9216 + r16 * 144 + quad * 16;
#pragma unroll
  for (int dt = 0; dt < 4; dt++) { vf[dt] = *(const bf16x8*)(vb + dt * 16 * 144); vf[4 + dt] = *(const bf16x8*)(vb + dt * 16 * 144 + 64); }
  wave_lds_sync();
  attn_compute64(kf, vf, key0, q0, q1, st, maskf, lane);
}
DI void attn_finish(AttnSt& st) {
  st.l += __shfl_xor(st.l, 16);
  st.l += __shfl_xor(st.l, 32);
}
DI void load_q(const bf16_t* qrow, int lane, bf16x8& q0, bf16x8& q1) {
  q0 = *(const bf16x8*)(qrow + (lane >> 4) * 8);
  q1 = *(const bf16x8*)(qrow + 32 + (lane >> 4) * 8);
}

DI void mem_attn_item(const bf16_t* qsrc, int qld, const bf16_t* zsrc, int zld, bf16_t* dst, int dld,
                      const bf16_t* memK, const bf16_t* memVT, int t0, int h, int lane, char* stage) {
  const int r16 = lane & 15, quad = lane >> 4;
  const int t = t0 + r16;
  bf16x8 q0, q1;
  load_q(qsrc + (size_t)t * qld + h * 64, lane, q0, q1);
  AttnSt st; attn_init(st);
  for (int key0 = 0; key0 < 256; key0 += 64)
    attn_block_lds(memK + h * 64, 256, memVT + (size_t)h * 64 * 256, 256, key0, q0, q1, st, [](int) { return true; }, stage, lane);
  attn_finish(st);
  const float inv = 1.f / fmaxf(st.l, 1e-30f);
#pragma unroll
  for (int dt = 0; dt < 4; dt++) {
    const int d = dt * 16 + quad * 4;
    uint2 zv = *(const uint2*)(zsrc + (size_t)t * zld + h * 64 + d);
    f32x4 o = st.o[dt];
    uint2 r;
    r.x = pack2(o[0] * inv * bflo(zv.x), o[1] * inv * bfhi(zv.x));
    r.y = pack2(o[2] * inv * bflo(zv.y), o[3] * inv * bfhi(zv.y));
    *(uint2*)(dst + (size_t)t * dld + h * 64 + d) = r;
  }
}

DI void moba_item(const bf16_t* PR0, const bf16_t* MVT, const bf16_t* KMEAN, bf16_t* CAT0, int* CNT, int* BUCKET,
                  float* LSESEL, float* LSEOWN, int t0, int h, int lane, char* stage) {
  const int r16 = lane & 15, quad = lane >> 4;
  const int t = t0 + r16;
  const int cur = t0 >> 8;
  bf16x8 q0, q1;
  load_q(PR0 + (size_t)t * LD0 + C_MQ + h * 64, lane, q0, q1);
  unsigned long long k1 = 0, k2 = 0, k3 = 0;
  auto ins = [&](unsigned long long k) {
    unsigned long long a = k1 > k ? k1 : k, r = k1 > k ? k : k1;
    k1 = a;
    a = k2 > r ? k2 : r; r = k2 > r ? r : k2;
    k2 = a;
    k3 = k3 > r ? k3 : r;
  };
  if (cur > 0) {
#pragma unroll
    for (int kt = 0; kt < 4; kt++) {
      f32x4 s = qk16(KMEAN + h * 64, 512, kt * 16, q0, q1, lane);
#pragma unroll
      for (int r = 0; r < 4; r++) {
        const int n = kt * 16 + quad * 4 + r;
        unsigned u = __float_as_uint(s[r]);
        u = (u & 0x80000000u) ? ~u : (u | 0x80000000u);
        unsigned long long key = (((unsigned long long)u) << 8) | (unsigned)(63 - n);
        if (n < cur) ins(key);
      }
    }
#pragma unroll
    for (int off = 16; off <= 32; off <<= 1) {
      unsigned long long o1, o2, o3;
      o1 = ((unsigned long long)__shfl_xor((unsigned)(k1 >> 32), off) << 32) | __shfl_xor((unsigned)k1, off);
      o2 = ((unsigned long long)__shfl_xor((unsigned)(k2 >> 32), off) << 32) | __shfl_xor((unsigned)k2, off);
      o3 = ((unsigned long long)__shfl_xor((unsigned)(k3 >> 32), off) << 32) | __shfl_xor((unsigned)k3, off);
      ins(o1); ins(o2); ins(o3);
    }
  }
  if (quad == 0) {
#pragma unroll
    for (int k = 0; k < 3; k++) {
      const unsigned long long kk = k == 0 ? k1 : (k == 1 ? k2 : k3);
      if (kk) {
        const int n = 63 - (int)(kk & 0xff);
        const int slot = atomicAdd(CNT + h * 64 + n, 1);
        BUCKET[(size_t)h * BUCKET_HEAD + n * T - 128 * n * (n + 1) + slot] = (t << 2) | k;
      } else {
        LSESEL[((size_t)t * 8 + h) * 3 + k] = -1e30f;
      }
    }
  }
  AttnSt st; attn_init(st);
  const bf16_t* Kb = PR0 + C_MK + h * 64;
  const bf16_t* Vb = MVT + (size_t)h * 64 * TP;
  for (int key0 = cur * 256; key0 <= t0 + 15; key0 += 64)
    attn_block_lds(Kb, LD0, Vb, TP, key0, q0, q1, st, [&](int key) { return key <= t; }, stage, lane);
  attn_finish(st);
  const float inv = 1.f / fmaxf(st.l, 1e-30f);
#pragma unroll
  for (int dt = 0; dt < 4; dt++) {
    const int d = dt * 16 + quad * 4;
    *(uint2*)(CAT0 + (size_t)t * 1280 + 512 + h * 64 + d) = pack4(st.o[dt] * inv);
  }
  if (quad == 0) LSEOWN[(size_t)t * 8 + h] = st.m + log2f(fmaxf(st.l, 1e-30f));
}

DI void moba_bucket_item(const bf16_t* PR0, const bf16_t* MVT, const int* BUCKET, char* ws, float* LSESEL,
                         int h, int n, int e0, int count, int lane) {
  const int r16 = lane & 15, quad = lane >> 4;
  const int* bk = BUCKET + (size_t)h * BUCKET_HEAD + n * T - 128 * n * (n + 1);
  bf16x8 q0[4], q1[4];
  int ent[4];
  AttnSt st[4];
#pragma unroll
  for (int ct = 0; ct < 4; ct++) {
    const int e = e0 + ct * 16 + r16;
    ent[ct] = e < count ? bk[e] : -1;
    const int t = ent[ct] >= 0 ? (ent[ct] >> 2) : 0;
    load_q(PR0 + (size_t)t * LD0 + C_MQ + h * 64, lane, q0[ct], q1[ct]);
    attn_init(st[ct]);
  }
  const bf16_t* Kb = PR0 + C_MK + h * 64;
  const bf16_t* Vb = MVT + (size_t)h * 64 * TP;
  for (int key0 = n * 256; key0 < n * 256 + 256; key0 += 32) {
    const bf16_t* kp = Kb + (size_t)(key0 + (r16 >> 2) * 8 + (r16 & 3)) * LD0 + quad * 8;
    const bf16x8 ka0 = *(const bf16x8*)kp, ka1 = *(const bf16x8*)(kp + 32);
    const bf16x8 kb0 = *(const bf16x8*)(kp + (size_t)4 * LD0), kb1 = *(const bf16x8*)(kp + (size_t)4 * LD0 + 32);
    const bf16_t* vp = Vb + (size_t)r16 * TP + key0 + quad * 8;
    bf16x8 vf[4];
#pragma unroll
    for (int dt = 0; dt < 4; dt++) vf[dt] = *(const bf16x8*)(vp + (size_t)dt * 16 * TP);
#pragma unroll
    for (int ct = 0; ct < 4; ct++) {
      f32x4 sa = {0.f, 0.f, 0.f, 0.f}, sb = {0.f, 0.f, 0.f, 0.f};
      sa = MFMA16(ka0, q0[ct], sa); sa = MFMA16(ka1, q1[ct], sa);
      sb = MFMA16(kb0, q0[ct], sb); sb = MFMA16(kb1, q1[ct], sb);
      const float lm = fmaxf(fmaxf(fmaxf(sa[0], sa[1]), fmaxf(sa[2], sa[3])), fmaxf(fmaxf(sb[0], sb[1]), fmaxf(sb[2], sb[3])));
      if (__ballot(lm > st[ct].m + 8.f) != 0ull) {
        float mx = fmaxf(lm, __shfl_xor(lm, 16));
        mx = fmaxf(mx, __shfl_xor(mx, 32));
        const float mn = (mx > st[ct].m + 8.f) ? mx : st[ct].m;
        const float alpha = ex2(st[ct].m - mn);
        st[ct].l *= alpha;
        st[ct].m = mn;
#pragma unroll
        for (int dt = 0; dt < 4; dt++) st[ct].o[dt] *= alpha;
      }
      f32x4 pa, pb;
#pragma unroll
      for (int r = 0; r < 4; r++) { pa[r] = ex2(sa[r] - st[ct].m); pb[r] = ex2(sb[r] - st[ct].m); }
      st[ct].l += (pa[0] + pa[1]) + (pa[2] + pa[3]) + (pb[0] + pb[1]) + (pb[2] + pb[3]);
      uint4 pu;
      pu.x = pack2(pa[0], pa[1]); pu.y = pack2(pa[2], pa[3]); pu.z = pack2(pb[0], pb[1]); pu.w = pack2(pb[2], pb[3]);
      const bf16x8 pf = __builtin_bit_cast(bf16x8, pu);
#pragma unroll
      for (int dt = 0; dt < 4; dt++) st[ct].o[dt] = MFMA16(vf[dt], pf, st[ct].o[dt]);
    }
  }
#pragma unroll
  for (int ct = 0; ct < 4; ct++) attn_finish(st[ct]);
  bf16_t* part = (bf16_t*)(ws + (h < 5 ? OFF_PARTA + (size_t)h * PART_HEAD : OFF_PARTB + (size_t)(h - 5) * PART_HEAD));
#pragma unroll
  for (int ct = 0; ct < 4; ct++) {
    if (ent[ct] < 0) continue;
    const int t = ent[ct] >> 2, k = ent[ct] & 3;
    const float inv = 1.f / fmaxf(st[ct].l, 1e-30f);
#pragma unroll
    for (int dt = 0; dt < 4; dt++)
      *(uint2*)(part + ((size_t)t * 3 + k) * 64 + dt * 16 + quad * 4) = pack4(st[ct].o[dt] * inv);
    if (quad == 0) LSESEL[((size_t)t * 8 + h) * 3 + k] = st[ct].m + log2f(fmaxf(st[ct].l, 1e-30f));
  }
}

DI void nsa_item(const bf16_t* PR0, const bf16_t* KC, const bf16_t* VCT, const bf16_t* VST, const bf16_t* VWT,
                 const float* NG, bf16_t* CAT0, int t0, int g, float* impw, unsigned* selw, int lane) {
  char* stage = (char*)impw;
  const int r16 = lane & 15, quad = lane >> 4;
  const int ql = r16 >> 2, hd = r16 & 3, H = g * 4 + hd;
  const int t = t0 + ql;
  const int cur = t0 >> 6;
  bf16x8 q0, q1;
  load_q(PR0 + (size_t)t * LD0 + C_NQ + H * 64, lane, q0, q1);
  const int nmax = (t >= 31) ? ((t - 31) >> 4) : -1;
  const int nmax_tile = (t0 + 3 >= 31) ? ((t0 + 3 - 31) >> 4) : -1;
  const bf16_t* Kc = KC + g * 64;
  const bf16_t* Vc = VCT + (size_t)g * 64 * 1024;
  AttnSt sc; attn_init(sc);
  for (int key0 = 0; key0 <= nmax_tile; key0 += 64)
    attn_block_lds(Kc, 128, Vc, 1024, key0, q0, q1, sc, [&](int n) { return n <= nmax; }, stage, lane);
  attn_finish(sc);
  if (cur >= 3) {
    const float invl = 1.f / fmaxf(sc.l, 1e-30f);
    float carry = 0.f;
    char* kst = stage + 9216;
    for (int key0 = 0; key0 <= nmax_tile; key0 += 32) {
      if ((key0 & 32) == 0) {
        wave_lds_sync();
        const int rsub = lane >> 3, ch = lane & 7;
        uint4 tk[8];
#pragma unroll
        for (int i = 0; i < 8; i++) tk[i] = *(const uint4*)(Kc + (size_t)(key0 + i * 8 + rsub) * 128 + ch * 8);
#pragma unroll
        for (int i = 0; i < 8; i++) *(uint4*)(kst + (i * 8 + rsub) * 144 + ch * 16) = tk[i];
        wave_lds_sync();
      }
      const char* kp = kst + ((key0 & 32) + (r16 >> 2) * 8 + (r16 & 3)) * 144 + quad * 16;
      f32x4 sa = {0.f, 0.f, 0.f, 0.f}, sb = {0.f, 0.f, 0.f, 0.f};
      sa = MFMA16(*(const bf16x8*)kp, q0, sa); sa = MFMA16(*(const bf16x8*)(kp + 64), q1, sa);
      sb = MFMA16(*(const bf16x8*)(kp + 4 * 144), q0, sb); sb = MFMA16(*(const bf16x8*)(kp + 4 * 144 + 64), q1, sb);
      float xa = 0.f, xb = 0.f, ea = 0.f, eb = 0.f;
#pragma unroll
      for (int r = 0; r < 4; r++) {
        float pa = (key0 + quad * 8 + r <= nmax) ? ex2(sa[r] - sc.m) * invl : 0.f;
        float pb = (key0 + quad * 8 + 4 + r <= nmax) ? ex2(sb[r] - sc.m) * invl : 0.f;
        xa += pa; xb += pb;
        if (r == 3) { ea = pa; eb = pb; }
      }
      const float eb_up = __shfl(eb, (lane - 16) & 63);
      const float eb_q3 = __shfl(eb, r16 + 48);
      float ia = xa + (quad > 0 ? eb_up : carry);
      float ib = xb + ea;
      carry = eb_q3;
      ia += __shfl_xor(ia, 1); ia += __shfl_xor(ia, 2);
      ib += __shfl_xor(ib, 1); ib += __shfl_xor(ib, 2);
      if (hd == 0) {
        impw[ql * 256 + (key0 >> 2) + 2 * quad] = ia;
        impw[ql * 256 + (key0 >> 2) + 2 * quad + 1] = ib;
      }
    }
  }
  wave_lds_sync();
  {
    const int nforced = cur == 0 ? 1 : (cur == 1 ? 2 : 3);
    const int R = 16 - nforced;
    const int hi = cur - 2;
    const int cnt = hi >= 1 ? hi : 0;
    const int sb = lane * 4;
    f32x4 vq[4];
    unsigned nib[4];
#pragma unroll
    for (int qq = 0; qq < 4; qq++) {
      vq[qq] = (f32x4){-1.f, -1.f, -1.f, -1.f};
      nib[qq] = 0u;
      if (cnt > 0) {
        const f32x4 iv = *(const f32x4*)(impw + qq * 256 + sb);
#pragma unroll
        for (int i = 0; i < 4; i++) if (sb + i >= 1 && sb + i <= hi) vq[qq][i] = iv[i];
      }
    }
    if (cnt <= R) {
#pragma unroll
      for (int qq = 0; qq < 4; qq++)
        nib[qq] = (vq[qq][0] >= 0.f ? 1u : 0u) | (vq[qq][1] >= 0.f ? 2u : 0u) | (vq[qq][2] >= 0.f ? 4u : 0u) | (vq[qq][3] >= 0.f ? 8u : 0u);
    } else {
      for (int round = 0; round < R; round++) {
        unsigned kh[4], kl[4];
#pragma unroll
        for (int qq = 0; qq < 4; qq++) {
          float bv = vq[qq][0]; int bi = 0;
          if (vq[qq][1] > bv) { bv = vq[qq][1]; bi = 1; }
          if (vq[qq][2] > bv) { bv = vq[qq][2]; bi = 2; }
          if (vq[qq][3] > bv) { bv = vq[qq][3]; bi = 3; }
          kh[qq] = bv >= 0.f ? (__float_as_uint(bv) | 0x80000000u) : 0u;
          kl[qq] = 255u - (unsigned)(sb + bi);
        }
#pragma unroll
        for (int off = 32; off > 0; off >>= 1) {
#pragma unroll
          for (int qq = 0; qq < 4; qq++) {
            const unsigned oh = __shfl_xor(kh[qq], off), ol = __shfl_xor(kl[qq], off);
            if (oh > kh[qq] || (oh == kh[qq] && ol > kl[qq])) { kh[qq] = oh; kl[qq] = ol; }
          }
        }
#pragma unroll
        for (int qq = 0; qq < 4; qq++) {
          const int sw = 255 - (int)kl[qq];
          if (kh[qq] != 0u && (sw >> 2) == lane) {
            const int i = sw & 3;
            if (i == 0) vq[qq][0] = -1.f; else if (i == 1) vq[qq][1] = -1.f; else if (i == 2) vq[qq][2] = -1.f; else vq[qq][3] = -1.f;
            nib[qq] |= 1u << i;
          }
        }
      }
    }
#pragma unroll
    for (int qq = 0; qq < 4; qq++) {
      unsigned w = nib[qq] << ((lane & 7) * 4);
      w |= __shfl_xor(w, 1); w |= __shfl_xor(w, 2); w |= __shfl_xor(w, 4);
      const int wi = lane >> 3;
      if (wi == 0) w |= 1u;
      if ((cur >> 5) == wi) w |= 1u << (cur & 31);
      if (cur >= 1 && ((cur - 1) >> 5) == wi) w |= 1u << ((cur - 1) & 31);
      if ((lane & 7) == 0) selw[qq * 8 + wi] = w;
    }
  }
  wave_lds_sync();
  f32x4 outv[4];
  {
    const float gc = NG[t * 32 + H] / fmaxf(sc.l, 1e-30f);
#pragma unroll
    for (int dt = 0; dt < 4; dt++) outv[dt] = sc.o[dt] * gc;
  }
  {
    AttnSt ss; attn_init(ss);
    const bf16_t* Kb = PR0 + C_KS + g * 64;
    const bf16_t* Vb = VST + (size_t)g * 64 * TP;
    for (int wd = 0; wd <= (cur >> 5); wd++) {
      const unsigned myw = selw[ql * 8 + wd];
      unsigned uw = __builtin_amdgcn_readfirstlane(selw[wd] | selw[8 + wd] | selw[16 + wd] | selw[24 + wd]);
      while (uw) {
        const int b = __builtin_ctz(uw);
        uw &= uw - 1u;
        const bool mine = (myw >> b) & 1u;
        attn_block_lds(Kb, LD0, Vb, TP, (wd * 32 + b) * 64, q0, q1, ss, [&](int key) { return mine && key <= t; }, stage, lane);
      }
    }
    attn_finish(ss);
    const float gs = NG[t * 32 + 8 + H] / fmaxf(ss.l, 1e-30f);
#pragma unroll
    for (int dt = 0; dt < 4; dt++) outv[dt] += ss.o[dt] * gs;
  }
  {
    AttnSt sw_; attn_init(sw_);
    const bf16_t* Kb = PR0 + C_KW + g * 64;
    const bf16_t* Vb = VWT + (size_t)g * 64 * TP;
    int start = t0 - 511; if (start < 0) start = 0;
    start &= ~63;
    for (int key0 = start; key0 <= t0 + 3; key0 += 64)
      attn_block_lds(Kb, LD0, Vb, TP, key0, q0, q1, sw_, [&](int key) { return key <= t && key > t - 512; }, stage, lane);
    attn_finish(sw_);
    const float gw = NG[t * 32 + 16 + H] / fmaxf(sw_.l, 1e-30f);
#pragma unroll
    for (int dt = 0; dt < 4; dt++) outv[dt] += sw_.o[dt] * gw;
  }
#pragma unroll
  for (int dt = 0; dt < 4; dt++) {
    const int d = dt * 16 + quad * 4;
    uint2 zv = *(const uint2*)(PR0 + (size_t)t * LD0 + C_NZ + H * 64 + d);
    const f32x4 a = outv[dt];
    uint2 r;
    r.x = pack2(a[0] * bflo(zv.x), a[1] * bfhi(zv.x));
    r.y = pack2(a[2] * bflo(zv.y), a[3] * bfhi(zv.y));
    *(uint2*)(CAT0 + (size_t)t * 1280 + H * 64 + d) = r;
  }
}

#define XB_TMO      128
#define XB_XCNT(j)  (256  + 64 * (j))
#define XB_XSUB(j)  (1280 + 64 * (j))
#define XB_XGEN(j)  (2304 + 64 * (j))
#define XB_TOP      3328
#define XB_TOPGEN   3392
#define XCD_BAR_WORDS 3456
#define XB_SPIN_CAP (1u << 18)
DI unsigned xb_ld(unsigned* p) { return __hip_atomic_load(p, __ATOMIC_RELAXED, __HIP_MEMORY_SCOPE_AGENT); }
DI unsigned xb_add(unsigned* p, unsigned v) { return __hip_atomic_fetch_add(p, v, __ATOMIC_RELAXED, __HIP_MEMORY_SCOPE_AGENT); }
DI unsigned xb_xcc_id() { return (unsigned)__builtin_amdgcn_s_getreg((3 << 11) | 20) & 0xFu; }
#define XB_SPIN(cond, bar) do { unsigned _sp = 0; while (cond) { __builtin_amdgcn_s_sleep(1); \
    if ((++_sp & 255u) == 0u) { if (xb_ld(&(bar)[XB_TMO])) break; if (_sp > XB_SPIN_CAP) { atomicAdd(&(bar)[XB_TMO], 1u); break; } } } } while (0)
struct XcdBarrier { unsigned* bar; unsigned x; unsigned nloc, nx; };
DI void xcd_barrier_complete(unsigned* bar, unsigned x, unsigned& nloc, unsigned& nx) {
  const unsigned G = gridDim.x * gridDim.y * gridDim.z;
  unsigned sum, cnt, mine, sp = 0u;
  for (;;) {
    sum = 0u; cnt = 0u; mine = 0u;
#pragma unroll
    for (unsigned j = 0; j < 16; ++j) { const unsigned c = xb_ld(&bar[XB_XCNT(j)]); sum += c; cnt += (c > 0u) ? 1u : 0u; mine = (j == x) ? c : mine; }
    if (sum == G) break;
    __builtin_amdgcn_s_sleep(1);
    if ((++sp & 255u) == 0u) { if (xb_ld(&bar[XB_TMO])) break; if (sp > XB_SPIN_CAP) { atomicAdd(&bar[XB_TMO], 1u); break; } }
  }
  nloc = mine > 0u ? mine : 1u; nx = cnt > 0u ? cnt : 1u;
}
DI void xcd_barrier(XcdBarrier& b) {
  asm volatile("s_waitcnt vmcnt(0)" ::: "memory");
  __syncthreads();
  if (threadIdx.x == 0) {
    unsigned* bar = b.bar;
    __builtin_amdgcn_s_waitcnt(0);
    if (b.nloc == 0u) xcd_barrier_complete(bar, b.x, b.nloc, b.nx);
    const unsigned nloc = b.nloc, nx = b.nx;
    const unsigned old = xb_add(&bar[XB_XSUB(b.x)], 1u);
    const unsigned gen = old / nloc;
    if (old + 1u == (gen + 1u) * nloc) {
      __builtin_amdgcn_fence(__ATOMIC_RELEASE, "agent");
      asm volatile("s_waitcnt vmcnt(0)" ::: "memory");
      const unsigned og = xb_add(&bar[XB_TOP], 1u);
      const unsigned tg = og / nx;
      if (og + 1u == (tg + 1u) * nx) xb_add(&bar[XB_TOPGEN], 1u);
      else XB_SPIN(xb_ld(&bar[XB_TOPGEN]) == tg, bar);
      __builtin_amdgcn_fence(__ATOMIC_ACQUIRE, "agent");
      xb_add(&bar[XB_XGEN(b.x)], 1u);
      asm volatile("s_waitcnt vmcnt(0)" ::: "memory");
    } else {
      XB_SPIN(xb_ld(&bar[XB_XGEN(b.x)]) == gen, bar);
      __builtin_amdgcn_fence(__ATOMIC_ACQUIRE, "agent");
      asm volatile("s_waitcnt vmcnt(0)" ::: "memory");
    }
  }
  __syncthreads();
}

#define PHASE_IDS                                                                                         \
  int tid_ = threadIdx.x;                                                                                 \
  asm volatile("" : "+v"(tid_));                                                                          \
  const int tid = tid_, lane = tid & 63, wave = tid >> 6, r16 = lane & 15, quad = lane >> 4, wm = wave >> 1, \
            wn = wave & 1, gw = bid * 4 + wave, gtid = bid * 256 + tid;                                   \
  (void)wm; (void)wn; (void)gw; (void)gtid; (void)r16; (void)quad; (void)lane; (void)tid;

DI void raster8(int sq, int TNN, int& tm_l, int& tn) {
  const int rg = sq / (8 * TNN), rem = sq % (8 * TNN);
  const int full = TNN >> 3;
  const int g = rem >> 6;
  if (g < full) { const int w = rem & 63; tm_l = rg * 8 + (w >> 3); tn = g * 8 + (w & 7); }
  else { const int r2 = rem - full * 64, w = TNN & 7; tm_l = rg * 8 + r2 / w; tn = full * 8 + r2 % w; }
}

__global__ void __launch_bounds__(256, 2) fwd_megakernel(Params p) {
  cg::grid_group grid = cg::this_grid();
  __shared__ __attribute__((aligned(16))) char smem_raw[81920];
  bf16_t* smem = (bf16_t*)smem_raw;
  const int tid = threadIdx.x, lane = tid & 63, wave = tid >> 6;
  const int r16 = lane & 15, quad = lane >> 4;
  const int wm = wave >> 1, wn = wave & 1;
  const int bid = blockIdx.x, nb = gridDim.x;
  const int gw = bid * 4 + wave, nw = nb * 4;
  const int gtid = bid * 256 + tid, nthr = nb * 256;
  char* ws = p.ws;
  bf16_t* Y0 = (bf16_t*)(ws + OFF_Y0);
  float* RSTD0 = (float*)(ws + OFF_RSTD0);
  float* RSTD1 = (float*)(ws + OFF_RSTD1);
  bf16_t* MEMN = (bf16_t*)(ws + OFF_MEMN);
  bf16_t* MEMK0 = (bf16_t*)(ws + OFF_MEMK0);
  bf16_t* MEMVT0 = (bf16_t*)(ws + OFF_MEMVT0);
  bf16_t* MEMK1 = (bf16_t*)(ws + OFF_MEMK1);
  bf16_t* MEMVT1 = (bf16_t*)(ws + OFF_MEMVT1);
  bf16_t* WMEM0T = (bf16_t*)(ws + OFF_WMEM0T);
  bf16_t* WMEM1T = (bf16_t*)(ws + OFF_WMEM1T);
  bf16_t* dO = (bf16_t*)p.out;
  unsigned long long* TS = (unsigned long long*)(ws + 33 * Mi + 262144);
  TSTAMP(0);
  XcdBarrier xb; xb.bar = (unsigned*)(ws + OFF_XBAR); xb.x = xb_xcc_id(); xb.nloc = 0u; xb.nx = 0u;
  if (threadIdx.x == 0) (void)xb_add(&xb.bar[XB_XCNT(xb.x)], 1u);

  {
    PHASE_IDS
    for (int t = gw; t < 256; t += nw) {
      const float4* xp = (const float4*)(p.mem + (size_t)t * 1024);
      float4 v[4]; float s = 0.f;
#pragma unroll
      for (int i = 0; i < 4; i++) { v[i] = xp[lane + i * 64]; s += v[i].x * v[i].x + v[i].y * v[i].y + v[i].z * v[i].z + v[i].w * v[i].w; }
#pragma unroll
      for (int o = 32; o > 0; o >>= 1) s += __shfl_xor(s, o);
      const float rs = rsqrtf(s * (1.f / 1024.f) + 1e-6f);
#pragma unroll
      for (int i = 0; i < 4; i++) {
        float4 gg = ((const float4*)p.mem_g)[lane + i * 64];
        uint2 r; r.x = pack2(v[i].x * rs * gg.x, v[i].y * rs * gg.y); r.y = pack2(v[i].z * rs * gg.z, v[i].w * rs * gg.w);
        *(uint2*)(MEMN + (size_t)t * 1024 + (lane + i * 64) * 4) = r;
      }
    }
    transpose_w(p.l0_wmem, 1024, 512, WMEM0T, 512, [](int n) { return n; }, (float*)smem_raw, bid, nb);
    transpose_w(p.l1_wmem, 1024, 512, WMEM1T, 512, [](int n) { return n; }, (float*)smem_raw, bid, nb);
#if DO_L0
    row_rstd(p.x, nullptr, RSTD0, (bf16_t*)(ws + OFF_XB0), T, gw, nw, lane);
    if (gtid < 512) ((int*)(ws + OFF_CNT))[gtid] = 0;
    transpose_w(p.l0_win, 1024, 4376, (bf16_t*)(ws + OFF_WT0), 4480,
                [](int n) { return n < 1280 ? n : (n < 4352 ? n + 24 : (n < 4376 ? n - 4352 + 1280 : -1)); },
                (float*)smem_raw, bid, nb, p.l0_g);
    transpose_w(p.l0_wout, 1280, 1024, (bf16_t*)(ws + OFF_WOUT0T), 1024, [](int n) { return n; }, (float*)smem_raw, bid, nb);
    transpose_w(p.w1_k, 2048, 64, (bf16_t*)(ws + OFF_W1KT), 64, [](int n) { return n; }, (float*)smem_raw, bid, nb);
    transpose_w(p.w1_v, 2048, 64, (bf16_t*)(ws + OFF_W1VT), 64, [](int n) { return n; }, (float*)smem_raw, bid, nb);
    transpose_w(p.w2_k, 64, 64, (bf16_t*)(ws + OFF_W2KT), 64, [](int n) { return n; }, (float*)smem_raw, bid, nb);
    transpose_w(p.w2_v, 64, 64, (bf16_t*)(ws + OFF_W2VT), 64, [](int n) { return n; }, (float*)smem_raw, bid, nb);
    {
      float* RC = (float*)(ws + OFF_ROPE0C); float* RS = (float*)(ws + OFF_ROPE0S);
      for (int i = gtid; i < T * 32; i += nthr) {
        const int t = i >> 5, d = i & 31;
        const double inv = exp2(-(double)d / 32.0 * 13.287712379549449);
        const double rev = (double)p.pos[t] * inv * 0.15915494309189535;
        const float fr = (float)(rev - floor(rev));
        RC[i] = __builtin_amdgcn_cosf(fr); RS[i] = __builtin_amdgcn_sinf(fr);
      }
    }
#endif
  }
  if (gridDim.x == 0x7fffffffu) grid.sync();
  xcd_barrier(xb);
  TSTAMP(1);

#if DO_L0
  {
    PHASE_IDS
    const bf16_t* WT0 = (const bf16_t*)(ws + OFF_WT0);
    bf16_t* PR0 = (bf16_t*)(ws + OFF_PR0);
    const float* RC = (const float*)(ws + OFF_ROPE0C); const float* RS = (const float*)(ws + OFF_ROPE0S);
    float* NG = (float*)(ws + OFF_NG);
    const bf16_t* XB0 = (const bf16_t*)(ws + OFF_XB0);
    for (int it = bid; it < 16; it += nb) {
        const int j = it, layer = j >> 3, tm = (j >> 2) & 1, tn = j & 3;
        const bf16_t* Wt = layer ? WMEM1T : WMEM0T;
        bf16_t* MK = layer ? MEMK1 : MEMK0; bf16_t* MV = layer ? MEMVT1 : MEMVT0;
        const int m0 = tm * 128, n0 = tn * 128;
        auto la = [&](int kt, int row, int ch) { return ld_bf(MEMN, 1024, m0 + row, kt, ch); };
        auto lb = [&](int kt, int row, int ch) { return ld_bf(Wt, 1024, n0 + row, kt, ch); };
        f32x4 acc[4][4]; zero_acc(acc);
        if (n0 < 256) {
          gemm_tile<4, 4, true>(acc, 16, la, lb, smem);
#pragma unroll
          for (int i = 0; i < 4; i++)
#pragma unroll
            for (int jj = 0; jj < 4; jj++) {
              const int m = m0 + wm * 64 + i * 16 + r16, n = n0 + wn * 64 + jj * 16 + quad * 4;
              *(uint2*)(MK + (size_t)m * 256 + n) = pack4(acc[i][jj]);
            }
        } else {
          gemm_tile<4, 4, false>(acc, 16, la, lb, smem);
#pragma unroll
          for (int i = 0; i < 4; i++)
#pragma unroll
            for (int jj = 0; jj < 4; jj++) {
              const int m = m0 + wm * 64 + i * 16 + quad * 4, n = n0 + wn * 64 + jj * 16 + r16 - 256;
              *(uint2*)(MV + (size_t)n * 256 + m) = pack4(acc[i][jj]);
            }
        }
    }
    const int xcd = bid & 7, lid = bid >> 3, nl = nb >> 3;
    for (int sq = lid; sq < 16 * 35; sq += nl) {
      int tml, tn; raster8(sq, 35, tml, tn);
      const int tm = xcd * 16 + tml;
      const int m0 = tm * 128, n0 = tn * 128;
      auto la = [&](int kt, int row, int ch) { return ld_bf(XB0, 1024, m0 + row, kt, ch); };
      auto lb = [&](int kt, int row, int ch) { return ld_bf(WT0, 1024, n0 + row, kt, ch); };
      f32x4 acc[4][4]; zero_acc(acc);
      const bool isT = (n0 == C_VS) || (n0 == C_VW) || (n0 >= C_MV && n0 < C_MZ);
      if (isT) {
        gemm_tile<4, 4, false>(acc, 16, la, lb, smem);
        bf16_t* dst; int nbase;
        if (n0 == C_VS) { dst = (bf16_t*)(ws + OFF_VST); nbase = C_VS; }
        else if (n0 == C_VW) { dst = (bf16_t*)(ws + OFF_VWT); nbase = C_VW; }
        else { dst = (bf16_t*)(ws + OFF_MVT); nbase = C_MV; }
#pragma unroll
        for (int i = 0; i < 4; i++)
#pragma unroll
          for (int jj = 0; jj < 4; jj++) {
            const int m = m0 + wm * 64 + i * 16 + quad * 4, n = n0 + wn * 64 + jj * 16 + r16 - nbase;
            const f32x4 rs4 = *(const f32x4*)(RSTD0 + m);
            *(uint2*)(dst + (size_t)n * TP + m) = pack4(acc[i][jj] * rs4);
          }
      } else {
        gemm_tile<4, 4, true>(acc, 16, la, lb, smem);
        const int nbw = n0 + wn * 64;
        const bool rope = (nbw < 640) || (nbw >= C_KS && nbw < C_VS) || (nbw >= C_KW && nbw < C_VW) || (nbw >= C_MQ && nbw < C_MV);
        const bool qs = (nbw < 512) || (nbw >= C_MQ && nbw < C_MK) || (nbw >= C_EQ && nbw < C_EZ);
        const bool sl = (nbw >= C_NZ && nbw < C_MQ) || (nbw >= C_MZ && nbw < C_EQ) || (nbw >= C_EZ && nbw < C_NG);
#pragma unroll
        for (int i = 0; i < 4; i++) {
          const int t = m0 + wm * 64 + i * 16 + r16;
          {
            const float rs = RSTD0[t];
#pragma unroll
            for (int jj = 0; jj < 4; jj++) acc[i][jj] *= rs;
          }
          if (n0 == C_NG) {
            if (wn == 0) {
#pragma unroll
              for (int jj = 0; jj < 2; jj++)
#pragma unroll
                for (int r = 0; r < 4; r++) {
                  const int idx = jj * 16 + quad * 4 + r;
                  if (idx < 24) NG[t * 32 + idx] = sigm_f(acc[i][jj][r] + p.l0_gb[idx]);
                }
            }
            continue;
          }
          if (rope) {
#pragma unroll
            for (int jj = 0; jj < 2; jj++) {
              const int d0 = jj * 16 + quad * 4;
              const f32x4 cc = *(const f32x4*)(RC + t * 32 + d0);
              const f32x4 ssn = *(const f32x4*)(RS + t * 32 + d0);
              f32x4 x1 = acc[i][jj], x2 = acc[i][jj + 2];
#pragma unroll
              for (int r = 0; r < 4; r++) {
                acc[i][jj][r] = x1[r] * cc[r] - x2[r] * ssn[r];
                acc[i][jj + 2][r] = x1[r] * ssn[r] + x2[r] * cc[r];
              }
            }
          }
#pragma unroll
          for (int jj = 0; jj < 4; jj++) {
            f32x4 v = acc[i][jj];
            if (qs) { v[0] *= QSCALE; v[1] *= QSCALE; v[2] *= QSCALE; v[3] *= QSCALE; }
            if (sl) { v[0] = silu_f(v[0]); v[1] = silu_f(v[1]); v[2] = silu_f(v[2]); v[3] = silu_f(v[3]); }
            *(uint2*)(PR0 + (size_t)t * LD0 + nbw + jj * 16 + quad * 4) = pack4(v);
          }
        }
      }
    }
  }
  xcd_barrier(xb);
  TSTAMP(2);

  {
    PHASE_IDS
    const bf16_t* PR0 = (const bf16_t*)(ws + OFF_PR0);
    bf16_t* KMEAN = (bf16_t*)(ws + OFF_KMEAN);
    bf16_t* HID = (bf16_t*)(ws + OFF_HID);
    for (int it = bid; it < 64 + 512; it += nb) {
      if (it >= 64) {
        const int j = it - 64, n = j >> 3, hd_ = (j & 7) * 64 + (tid & 63), part = tid >> 6;
        float s = 0.f;
#pragma unroll 8
        for (int r = 0; r < 64; r++) s += bf2f(PR0[(size_t)(n * 256 + part * 64 + r) * LD0 + C_MK + hd_]);
        float* red = (float*)smem_raw;
        red[tid] = s;
        __syncthreads();
        if (part == 0) KMEAN[n * 512 + hd_] = f2bf((red[tid] + red[tid + 64] + red[tid + 128] + red[tid + 192]) * (1.f / 256.f));
        __syncthreads();
        continue;
      }
      const int var = it >> 4, mt = it & 15;
      const int isv = var >> 1, g = var & 1;
      const int m0 = mt * 64;
      const int coff = (isv ? C_VCI : C_KCI) + g * 64;
      const bf16_t* W1T = (const bf16_t*)(ws + (isv ? OFF_W1VT : OFF_W1KT));
      const bf16_t* W2T = (const bf16_t*)(ws + (isv ? OFF_W2VT : OFF_W2KT));
      const float* pe = isv ? p.pe_v : p.pe_k;
      auto la = [&](int kt, int row, int ch) -> uint4 {
        const int n = m0 + row;
        if (n > 1022) return make_uint4(0, 0, 0, 0);
        const uint4 av = *(const uint4*)(PR0 + (size_t)(16 * n + kt) * LD0 + coff + ch * 8);
        const float4 p0 = *(const float4*)(pe + kt * 64 + ch * 8), p1 = *(const float4*)(pe + kt * 64 + ch * 8 + 4);
        uint4 r;
        r.x = pack2(bflo(av.x) + p0.x, bfhi(av.x) + p0.y); r.y = pack2(bflo(av.y) + p0.z, bfhi(av.y) + p0.w);
        r.z = pack2(bflo(av.z) + p1.x, bfhi(av.z) + p1.y); r.w = pack2(bflo(av.w) + p1.z, bfhi(av.w) + p1.w);
        return r;
      };
      auto lb = [&](int kt, int row, int ch) { return ld_bf(W1T, 2048, row, kt, ch); };
      f32x4 acc[2][2]; zero_acc(acc);
      gemm_tile<2, 2, true>(acc, 32, la, lb, smem);
      bf16_t* hid = HID + (size_t)var * 1024 * 64;
#pragma unroll
      for (int i = 0; i < 2; i++)
#pragma unroll
        for (int jj = 0; jj < 2; jj++) {
          const int m = m0 + wm * 32 + i * 16 + r16, n = wn * 32 + jj * 16 + quad * 4;
          f32x4 v = acc[i][jj];
#pragma unroll
          for (int r = 0; r < 4; r++) v[r] = silu_f(v[r]);
          *(uint2*)(hid + (size_t)m * 64 + n) = pack4(v);
        }
      __threadfence_block();
      __syncthreads();
      auto la2 = [&](int kt, int row, int ch) { return ld_bf(hid, 64, m0 + row, kt, ch); };
      auto lb2 = [&](int kt, int row, int ch) { return ld_bf(W2T, 64, row, kt, ch); };
      f32x4 acc2[2][2]; zero_acc(acc2);
      if (!isv) {
        gemm_tile<2, 2, true>(acc2, 1, la2, lb2, smem);
        bf16_t* KC = (bf16_t*)(ws + OFF_KC);
#pragma unroll
        for (int i = 0; i < 2; i++)
#pragma unroll
          for (int jj = 0; jj < 2; jj++) {
            const int m = m0 + wm * 32 + i * 16 + r16, n = wn * 32 + jj * 16 + quad * 4;
            *(uint2*)(KC + (size_t)m * 128 + g * 64 + n) = pack4(acc2[i][jj]);
          }
      } else {
        gemm_tile<2, 2, false>(acc2, 1, la2, lb2, smem);
        bf16_t* VCT = (bf16_t*)(ws + OFF_VCT);
#pragma unroll
        for (int i = 0; i < 2; i++)
#pragma unroll
          for (int jj = 0; jj < 2; jj++) {
            const int m = m0 + wm * 32 + i * 16 + quad * 4, n = wn * 32 + jj * 16 + r16;
            *(uint2*)(VCT + (size_t)(g * 64 + n) * 1024 + m) = pack4(acc2[i][jj]);
          }
      }
    }
  }
  xcd_barrier(xb);
  TSTAMP(3);

  {
    PHASE_IDS
    const bf16_t* PR0 = (const bf16_t*)(ws + OFF_PR0);
    float* impw = (float*)(smem_raw + wave * 18432);
    unsigned* selw = (unsigned*)(smem_raw + 73728) + wave * 32;
    const int N_NSA = 4096 * 2, N_MOBA = 1024 * 8, N_MEM = 1024 * 4;
    for (int it = gw; it < N_NSA + N_MOBA + N_MEM; it += nw) {
      if (it < N_NSA) {
        const int qt = it >> 1, g = it & 1;
        nsa_item(PR0, (const bf16_t*)(ws + OFF_KC), (const bf16_t*)(ws + OFF_VCT), (const bf16_t*)(ws + OFF_VST),
                 (const bf16_t*)(ws + OFF_VWT), (const float*)(ws + OFF_NG), dO, qt * 4, g, impw, selw, lane);
      } else if (it < N_NSA + N_MOBA) {
        const int j = it - N_NSA;
        moba_item(PR0, (const bf16_t*)(ws + OFF_MVT), (const bf16_t*)(ws + OFF_KMEAN), dO, (int*)(ws + OFF_CNT),
                  (int*)((char*)p.out + DOFF_BUCKET), (float*)(ws + OFF_LSESEL), (float*)(ws + OFF_LSEOWN), (j >> 3) * 16, j & 7, lane, (char*)impw);
      } else {
        const int j = it - N_NSA - N_MOBA;
        mem_attn_item(PR0 + C_EQ, LD0, PR0 + C_EZ, LD0, dO + 1024, 1280, MEMK0, MEMVT0, (j >> 2) * 16, j & 3, lane, (char*)impw);
      }
    }
  }
  xcd_barrier(xb);
  TSTAMP(4);

  {
    PHASE_IDS
    const bf16_t* PR0 = (const bf16_t*)(ws + OFF_PR0);
    const int* CNT = (const int*)(ws + OFF_CNT);
    unsigned tcl = 0, tch = 0;
    int lsum = 0;
#pragma unroll
    for (int i = 0; i < 8; i++) {
      const int c = (CNT[lane * 8 + i] + 63) >> 6;
      lsum += c;
      if (i < 4) tcl |= (unsigned)c << (8 * i); else tch |= (unsigned)c << (8 * (i - 4));
    }
    int incl = lsum;
#pragma unroll
    for (int o = 1; o < 64; o <<= 1) { int v = __shfl_up(incl, o); if (lane >= o) incl += v; }
    const int excl = incl - lsum;
    const int total = __shfl(incl, 63);
    for (int it = gw; it < total; it += nw) {
      const unsigned long long bal = __ballot(excl <= it);
      const int owner = 63 - __builtin_clzll(bal);
      int rem = it - excl, pi = 0, tj = 0;
#pragma unroll
      for (int i = 0; i < 8; i++) {
        const int c = (int)(((i < 4 ? tcl : tch) >> (8 * (i & 3))) & 0xffu);
        if (rem >= 0 && rem < c) { pi = i; tj = rem; rem = -1; }
        else if (rem >= 0) rem -= c;
      }
      const int pair = owner * 8 + __shfl(pi, owner);
      const int tile = __shfl(tj, owner);
      const int count = CNT[pair];
      moba_bucket_item(PR0, (const bf16_t*)(ws + OFF_MVT), (const int*)((char*)p.out + DOFF_BUCKET), ws,
                       (float*)(ws + OFF_LSESEL), pair >> 6, pair & 63, tile * 64, count, lane);
    }
  }
  xcd_barrier(xb);
  {
    PHASE_IDS
    const bf16_t* PR0 = (const bf16_t*)(ws + OFF_PR0);
    const float* LSESEL = (const float*)(ws + OFF_LSESEL);
    const float* LSEOWN = (const float*)(ws + OFF_LSEOWN);
    for (int i = gtid; i < T * 64; i += nthr) {
      const int c8 = i & 7, h = (i >> 3) & 7, t = i >> 6;
      const float lo = LSEOWN[(size_t)t * 8 + h];
      const float l0 = LSESEL[((size_t)t * 8 + h) * 3 + 0], l1 = LSESEL[((size_t)t * 8 + h) * 3 + 1], l2 = LSESEL[((size_t)t * 8 + h) * 3 + 2];
      const float M = fmaxf(fmaxf(lo, l0), fmaxf(l1, l2));
      float wo = ex2(lo - M), w0 = ex2(l0 - M), w1 = ex2(l1 - M), w2 = ex2(l2 - M);
      const float inv = 1.f / (wo + w0 + w1 + w2);
      wo *= inv; w0 *= inv; w1 *= inv; w2 *= inv;
      const bf16_t* part = (const bf16_t*)(ws + (h < 5 ? OFF_PARTA + (size_t)h * PART_HEAD : OFF_PARTB + (size_t)(h - 5) * PART_HEAD)) + (size_t)t * 192 + c8 * 8;
      bf16_t* dst = dO + (size_t)t * 1280 + 512 + h * 64 + c8 * 8;
      const uint4 ov = *(const uint4*)dst;
      const uint4 zv = *(const uint4*)(PR0 + (size_t)t * LD0 + C_MZ + h * 64 + c8 * 8);
      uint4 a0 = make_uint4(0, 0, 0, 0), a1 = a0, a2 = a0;
      if (w0 > 0.f) a0 = *(const uint4*)(part);
      if (w1 > 0.f) a1 = *(const uint4*)(part + 64);
      if (w2 > 0.f) a2 = *(const uint4*)(part + 128);
      const unsigned ou[4] = {ov.x, ov.y, ov.z, ov.w}, zu[4] = {zv.x, zv.y, zv.z, zv.w};
      const unsigned u0[4] = {a0.x, a0.y, a0.z, a0.w}, u1[4] = {a1.x, a1.y, a1.z, a1.w}, u2[4] = {a2.x, a2.y, a2.z, a2.w};
      unsigned ru[4];
#pragma unroll
      for (int j = 0; j < 4; j++) {
        const float lo_ = (wo * bflo(ou[j]) + w0 * bflo(u0[j]) + w1 * bflo(u1[j]) + w2 * bflo(u2[j])) * bflo(zu[j]);
        const float hi_ = (wo * bfhi(ou[j]) + w0 * bfhi(u0[j]) + w1 * bfhi(u1[j]) + w2 * bfhi(u2[j])) * bfhi(zu[j]);
        ru[j] = pack2(lo_, hi_);
      }
      *(uint4*)dst = make_uint4(ru[0], ru[1], ru[2], ru[3]);
    }
  }
  xcd_barrier(xb);
  {
    PHASE_IDS
    const bf16_t* WO = (const bf16_t*)(ws + OFF_WOUT0T);
    const int xcd = bid & 7, lid = bid >> 3, nl = nb >> 3;
    for (int sq = lid; sq < 16 * 8; sq += nl) {
      int tml, tn; raster8(sq, 8, tml, tn);
      const int tm = xcd * 16 + tml;
      const int m0 = tm * 128, n0 = tn * 128;
      auto la = [&](int kt, int row, int ch) { return ld_bf(dO, 1280, m0 + row, kt, ch); };
      auto lb = [&](int kt, int row, int ch) { return ld_bf(WO, 1280, n0 + row, kt, ch); };
      f32x4 acc[4][4]; zero_acc(acc);
      gemm_tile<4, 4, true>(acc, 20, la, lb, smem);
#pragma unroll
      for (int i = 0; i < 4; i++)
#pragma unroll
        for (int jj = 0; jj < 4; jj++) {
          const int m = m0 + wm * 64 + i * 16 + r16, n = n0 + wn * 64 + jj * 16 + quad * 4;
          const f32x4 xv = *(const f32x4*)(p.x + (size_t)m * 1024 + n);
          *(uint2*)(Y0 + (size_t)m * 1024 + n) = pack4(acc[i][jj] + xv);
        }
    }
  }
  xcd_barrier(xb);
  TSTAMP(5);
#else
  {
    for (int i = gtid; i < T * 1024 / 4; i += nthr) { const float4 v = ((const float4*)p.x)[i]; uint2 o; o.x = pack2(v.x, v.y); o.y = pack2(v.z, v.w); ((uint2*)Y0)[i] = o; }
    for (int it = bid; it < 8; it += nb) {
      const int tm = (it >> 2) & 1, tn = it & 3;
      const int m0 = tm * 128, n0 = tn * 128;
      auto la = [&](int kt, int row, int ch) { return ld_bf(MEMN, 1024, m0 + row, kt, ch); };
      auto lb = [&](int kt, int row, int ch) { return ld_bf(WMEM1T, 1024, n0 + row, kt, ch); };
      f32x4 acc[4][4]; zero_acc(acc);
      if (n0 < 256) {
        gemm_tile<4, 4, true>(acc, 16, la, lb, smem);
#pragma unroll
        for (int i = 0; i < 4; i++)
#pragma unroll
          for (int jj = 0; jj < 4; jj++) {
            const int m = m0 + wm * 64 + i * 16 + r16, n = n0 + wn * 64 + jj * 16 + quad * 4;
            *(uint2*)(MEMK1 + (size_t)m * 256 + n) = pack4(acc[i][jj]);
          }
      } else {
        gemm_tile<4, 4, false>(acc, 16, la, lb, smem);
#pragma unroll
        for (int i = 0; i < 4; i++)
#pragma unroll
          for (int jj = 0; jj < 4; jj++) {
            const int m = m0 + wm * 64 + i * 16 + quad * 4, n = n0 + wn * 64 + jj * 16 + r16 - 256;
            *(uint2*)(MEMVT1 + (size_t)n * 256 + m) = pack4(acc[i][jj]);
          }
      }
    }
  }
  xcd_barrier(xb);
  TSTAMP(5);
#endif

  {
    PHASE_IDS
    for (int t = gw; t < T; t += nw) {
      const uint4 a = *(const uint4*)(Y0 + (size_t)t * 1024 + lane * 8), b = *(const uint4*)(Y0 + (size_t)t * 1024 + 512 + lane * 8);
      const unsigned u[8] = {a.x, a.y, a.z, a.w, b.x, b.y, b.z, b.w};
      float sq = 0.f;
#pragma unroll
      for (int i = 0; i < 8; i++) { const float lo = bflo(u[i]), hi = bfhi(u[i]); sq += lo * lo + hi * hi; }
#pragma unroll
      for (int o = 32; o > 0; o >>= 1) sq += __shfl_xor(sq, o);
      if (lane == 0) RSTD1[t] = rsqrtf(sq * (1.f / 1024.f) + 1e-6f);
    }
    auto perm = [](int x) { const int h = x >> 8, r = x & 255; return h * 256 + ((r >> 5) & 1) * 128 + (r >> 6) * 32 + (r & 31); };
    transpose_w(p.l1_win, 1024, 6656, (bf16_t*)(ws + OFF_WT1), 4608,
                [&](int n) { return n < 1024 ? perm(n) : (n < 2048 ? 1024 + perm(n - 1024) : (n < 4096 ? n : n + 2048)); },
                (float*)smem_raw, bid, nb, p.l1_g);
    transpose_w(p.l1_win, 1024, 6656, (bf16_t*)(ws + OFF_WRZT), 2048, [](int n) { return 4096 + n; }, (float*)smem_raw, bid, nb, p.l1_g);
    transpose_w(p.l1_wout, 2304, 1024, (bf16_t*)(ws + OFF_WOUT1T), 1024, [](int n) { return n; }, (float*)smem_raw, bid, nb);
    float* RC = (float*)(ws + OFF_ROPE1C); float* RS = (float*)(ws + OFF_ROPE1S);
    for (int i = gtid; i < T * 128; i += nthr) {
      const int t = i >> 7, d = i & 127;
      const double inv = exp2(-(double)d / 127.0 * 13.287712379549449);
      const double rev = (double)p.pos[t] * inv * 0.15915494309189535;
      const float fr = (float)(rev - floor(rev));
      RC[i] = __builtin_amdgcn_cosf(fr); RS[i] = __builtin_amdgcn_sinf(fr);
    }
  }
  xcd_barrier(xb);
  TSTAMP(6);

  bf16_t* Q1 = dO;
  bf16_t* P1 = (bf16_t*)((char*)p.out + DOFF_P);
  bf16_t* KP = (bf16_t*)(ws + OFF_KP);
  bf16_t* KPT = (bf16_t*)(ws + OFF_KPT);
  bf16_t* VT = (bf16_t*)(ws + OFF_VT);
  bf16_t* S1 = (bf16_t*)(ws + OFF_S);
  bf16_t* EQ1 = (bf16_t*)(ws + OFF_EQ1);
  bf16_t* EZ1 = (bf16_t*)(ws + OFF_EZ1);
  bf16_t* O1 = (bf16_t*)(ws + OFF_O);
  bf16_t* Z1 = (bf16_t*)(ws + OFF_Z);

  {
    PHASE_IDS
    const bf16_t* WT1 = (const bf16_t*)(ws + OFF_WT1);
    const float* RC = (const float*)(ws + OFF_ROPE1C); const float* RS = (const float*)(ws + OFF_ROPE1S);
    const bf16_t* XB1 = Y0;
    const int xcd = bid & 7, lid = bid >> 3, nl = nb >> 3;
    for (int sq = lid; sq < 16 * 36; sq += nl) {
      int tml, tn; raster8(sq, 36, tml, tn);
      const int tm = xcd * 16 + tml;
      const int m0 = tm * 128, n0 = tn * 128;
      auto la = [&](int kt, int row, int ch) { return ld_bf(XB1, 1024, m0 + row, kt, ch); };
      auto lb = [&](int kt, int row, int ch) { return ld_bf(WT1, 1024, n0 + row, kt, ch); };
      f32x4 acc[4][4]; zero_acc(acc);
      if (n0 >= 2048 && n0 < 4096) {
        gemm_tile<4, 4, false>(acc, 16, la, lb, smem);
#pragma unroll
        for (int i = 0; i < 4; i++)
#pragma unroll
          for (int jj = 0; jj < 4; jj++) {
            const int m = m0 + wm * 64 + i * 16 + quad * 4, n = n0 + wn * 64 + jj * 16 + r16 - 2048;
            const f32x4 rs4 = *(const f32x4*)(RSTD1 + m);
            *(uint2*)(VT + (size_t)n * TP + m) = pack4(acc[i][jj] * rs4);
          }
      } else {
        gemm_tile<4, 4, true>(acc, 16, la, lb, smem);
        const int nbw = n0 + wn * 64;
#pragma unroll
        for (int i = 0; i < 4; i++) {
          const int t = m0 + wm * 64 + i * 16 + r16;
          {
            const float rs = RSTD1[t];
#pragma unroll
            for (int jj = 0; jj < 4; jj++) acc[i][jj] *= rs;
          }
          if (nbw < 2048) {
            const int cgrp = (nbw & 255) >> 6;
#pragma unroll
            for (int jj = 0; jj < 2; jj++) {
              const int d0 = cgrp * 32 + jj * 16 + quad * 4;
              const f32x4 cc = *(const f32x4*)(RC + t * 128 + d0);
              const f32x4 ssn = *(const f32x4*)(RS + t * 128 + d0);
              f32x4 x1 = acc[i][jj], x2 = acc[i][jj + 2];
#pragma unroll
              for (int r = 0; r < 4; r++) {
                acc[i][jj][r] = x1[r] * cc[r] - x2[r] * ssn[r];
                acc[i][jj + 2][r] = x1[r] * ssn[r] + x2[r] * cc[r];
              }
            }
            if (nbw < 1024) {
#pragma unroll
              for (int jj = 0; jj < 4; jj++)
                *(uint2*)(Q1 + (size_t)t * 1024 + nbw + jj * 16 + quad * 4) = pack4(acc[i][jj]);
            } else {
              const int h = (nbw - 1024) >> 8;
              const float lg = log2f(1.f - exp2f(-5.f - (float)h));
              const float ksc = 0.0625f * exp2f(-(float)((t & 255) + 1) * lg);
#pragma unroll
              for (int jj = 0; jj < 4; jj++) {
                f32x4 v = acc[i][jj];
                v[0] *= ksc; v[1] *= ksc; v[2] *= ksc; v[3] *= ksc;
                const int n = nbw - 1024 + jj * 16 + quad * 4;
                *(uint2*)(KP + (size_t)t * 1024 + n) = pack4(v);
#pragma unroll
                for (int r = 0; r < 4; r++) KPT[(size_t)(n + r) * TP + t] = f2bf(v[r]);
              }
            }
          } else if (nbw < 4352) {
#pragma unroll
            for (int jj = 0; jj < 4; jj++) {
              f32x4 v = acc[i][jj];
              v[0] *= QSCALE; v[1] *= QSCALE; v[2] *= QSCALE; v[3] *= QSCALE;
              *(uint2*)(EQ1 + (size_t)t * 256 + nbw - 4096 + jj * 16 + quad * 4) = pack4(v);
            }
          } else {
#pragma unroll
            for (int jj = 0; jj < 4; jj++) {
              f32x4 v = acc[i][jj];
              v[0] = silu_f(v[0]); v[1] = silu_f(v[1]); v[2] = silu_f(v[2]); v[3] = silu_f(v[3]);
              *(uint2*)(EZ1 + (size_t)t * 256 + nbw - 4352 + jj * 16 + quad * 4) = pack4(v);
            }
          }
        }
      }
    }
  }
  xcd_barrier(xb);
  TSTAMP(7);

  {
    PHASE_IDS
    const int xcd7 = bid & 7, lid7 = bid >> 3, nl7 = nb >> 3;
    for (int sq = lid7; sq < 512; sq += nl7) {
      const int it = xcd7 * 512 + sq;
      if (it < 2048) {
        const int h = it >> 9, c = (it >> 3) & 63, tm = (it >> 1) & 3, tn = it & 1;
        const bf16_t* Ab = VT + (size_t)(h * 512 + tm * 128) * TP + c * 256;
        const bf16_t* Bb = KPT + (size_t)(h * 256 + tn * 128) * TP + c * 256;
        auto la = [&](int kt, int row, int ch) { return ld_bf(Ab, TP, row, kt, ch); };
        auto lb = [&](int kt, int row, int ch) { return ld_bf(Bb, TP, row, kt, ch); };
        f32x4 acc[4][4]; zero_acc(acc);
        gemm_tile<4, 4, true>(acc, 4, la, lb, smem);
        bf16_t* Sd = S1 + ((size_t)(h * 64 + c) * 512 + tm * 128) * 256 + tn * 128;
#pragma unroll
        for (int i = 0; i < 4; i++)
#pragma unroll
          for (int jj = 0; jj < 4; jj++) {
            const int m = wm * 64 + i * 16 + r16, n = wn * 64 + jj * 16 + quad * 4;
            *(uint2*)(Sd + (size_t)m * 256 + n) = pack4(acc[i][jj]);
          }
      } else if (it < 3072) {
        const int j = it - 2048;
        const int h = j >> 8, c = (j >> 2) & 63, tm = (j >> 1) & 1, tn = j & 1;
        const int m0 = c * 256 + tm * 128, n0 = c * 256 + tn * 128;
        auto la = [&](int kt, int row, int ch) { return ld_bf(Q1 + h * 256, 1024, m0 + row, kt, ch); };
        auto lb = [&](int kt, int row, int ch) { return ld_bf(KP + h * 256, 1024, n0 + row, kt, ch); };
        f32x4 acc[4][4]; zero_acc(acc);
        if (tn <= tm) gemm_tile<4, 4, true>(acc, 4, la, lb, smem);
#pragma unroll
        for (int i = 0; i < 4; i++)
#pragma unroll
          for (int jj = 0; jj < 4; jj++) {
            const int m = m0 + wm * 64 + i * 16 + r16, n = n0 + wn * 64 + jj * 16 + quad * 4;
            f32x4 v = acc[i][jj];
#pragma unroll
            for (int r = 0; r < 4; r++) if (n + r > m) v[r] = 0.f;
            *(uint2*)(P1 + ((size_t)h * T + m) * 256 + (n - c * 256)) = pack4(v);
          }
      } else {
        const int j = (it - 3072) * 4 + wave;
        mem_attn_item(EQ1, 256, EZ1, 256, EQ1, 256, MEMK1, MEMVT1, (j >> 2) * 16, j & 3, lane, smem_raw + wave * 18432);
      }
    }
  }
  xcd_barrier(xb);
  {
    PHASE_IDS
    for (int e = gtid; e < 4 * 16384; e += nthr) {
      const int h = e >> 14, idx = (e & 16383) * 8;
      const float gL = exp2f(256.f * log2f(1.f - exp2f(-5.f - (float)h)));
      float s0 = 0.f, s1 = 0.f, s2 = 0.f, s3 = 0.f, s4 = 0.f, s5 = 0.f, s6 = 0.f, s7 = 0.f;
      bf16_t* base = S1 + (((size_t)h * 64) << 17) + idx;
      for (int c0 = 0; c0 < 64; c0 += 8) {
        uint4 u[8];
#pragma unroll
        for (int i = 0; i < 8; i++) u[i] = *(const uint4*)(base + ((size_t)(c0 + i) << 17));
#pragma unroll
        for (int i = 0; i < 8; i++) {
          uint4 o;
          o.x = pack2(s0, s1); o.y = pack2(s2, s3); o.z = pack2(s4, s5); o.w = pack2(s6, s7);
          *(uint4*)(base + ((size_t)(c0 + i) << 17)) = o;
          s0 = gL * (s0 + bflo(u[i].x)); s1 = gL * (s1 + bfhi(u[i].x));
          s2 = gL * (s2 + bflo(u[i].y)); s3 = gL * (s3 + bfhi(u[i].y));
          s4 = gL * (s4 + bflo(u[i].z)); s5 = gL * (s5 + bfhi(u[i].z));
          s6 = gL * (s6 + bflo(u[i].w)); s7 = gL * (s7 + bfhi(u[i].w));
        }
      }
    }
  }
  xcd_barrier(xb);
  TSTAMP(8);

  {
    PHASE_IDS
    const int xcd8 = bid & 7, lid8 = bid >> 3, nl8 = nb >> 3;
    for (int sq = lid8; sq < 256; sq += nl8) {
      const int it = xcd8 * 256 + sq;
      const int h = it >> 9, c = (it >> 3) & 63, tm = (it >> 2) & 1, tn = it & 3;
      const int m0 = c * 256 + tm * 128, n0 = tn * 128;
      const bf16_t* Sb = S1 + ((size_t)(h * 64 + c) * 512 + n0) * 256;
      const bf16_t* Pb = P1 + ((size_t)h * T + m0) * 256;
      const bf16_t* Vb = VT + (size_t)(h * 512 + n0) * TP + c * 256;
      const bf16_t* Qb = Q1 + (size_t)m0 * 1024 + h * 256;
      auto la = [&](int kt, int row, int ch) {
        const bf16_t* b = kt < 4 ? Qb : Pb; const int ld = kt < 4 ? 1024 : 256;
        return *(const uint4*)(b + (size_t)(row * ld) + (kt & 3) * 64 + ch * 8);
      };
      auto lb = [&](int kt, int row, int ch) {
        const bf16_t* b = kt < 4 ? Sb : Vb; const int ld = kt < 4 ? 256 : TP;
        return *(const uint4*)(b + (size_t)(row * ld) + (kt & 3) * 64 + ch * 8);
      };
      f32x4 acc[4][4]; zero_acc(acc);
      gemm_tile<4, 4, true>(acc, tm == 0 ? 6 : 8, la, lb, smem);
      const float lg = log2f(1.f - exp2f(-5.f - (float)h));
#pragma unroll
      for (int i = 0; i < 4; i++) {
        const int t = m0 + wm * 64 + i * 16 + r16;
        const float qd = exp2f((float)((t & 255) + 1) * lg);
#pragma unroll
        for (int jj = 0; jj < 4; jj++) {
          f32x4 v = acc[i][jj];
          v[0] *= qd; v[1] *= qd; v[2] *= qd; v[3] *= qd;
          *(uint2*)(O1 + (size_t)t * 2048 + h * 512 + n0 + wn * 64 + jj * 16 + quad * 4) = pack4(v);
        }
      }
    }
  }
  xcd_barrier(xb);
  TSTAMP(9);

  {
    PHASE_IDS
    const bf16_t* WRZT = (const bf16_t*)(ws + OFF_WRZT);
    const int xcd = bid & 7, lid = bid >> 3, nl = nb >> 3;
    for (int sq = lid; sq < 16 * 16; sq += nl) {
      int tml, tn; raster8(sq, 16, tml, tn);
      const int tm = xcd * 16 + tml;
      const int m0 = tm * 128, n0 = tn * 128;
      auto la = [&](int kt, int row, int ch) { return ld_bf(Y0, 1024, m0 + row, kt, ch); };
      auto lb = [&](int kt, int row, int ch) { return ld_bf(WRZT, 1024, n0 + row, kt, ch); };
      f32x4 acc[4][4]; zero_acc(acc);
      gemm_tile<4, 4, true>(acc, 16, la, lb, smem);
#pragma unroll
      for (int i = 0; i < 4; i++)
#pragma unroll
        for (int jj = 0; jj < 4; jj++) {
          const int m = m0 + wm * 64 + i * 16 + r16, n = n0 + wn * 64 + jj * 16 + quad * 4;
          f32x4 v = acc[i][jj] * RSTD1[m];
          v[0] = silu_f(v[0]); v[1] = silu_f(v[1]); v[2] = silu_f(v[2]); v[3] = silu_f(v[3]);
          *(uint2*)(Z1 + (size_t)m * 2048 + n) = pack4(v);
        }
    }
  }
  xcd_barrier(xb);
  TSTAMP(10);

  {
    PHASE_IDS
    for (int it = gw; it < T * 4; it += nw) {
      const size_t off = (size_t)it * 512 + lane * 8;
      uint4 ov = *(const uint4*)(O1 + off);
      uint4 zv = *(const uint4*)(Z1 + off);
      float o[8] = {bflo(ov.x), bfhi(ov.x), bflo(ov.y), bfhi(ov.y), bflo(ov.z), bfhi(ov.z), bflo(ov.w), bfhi(ov.w)};
      float z[8] = {bflo(zv.x), bfhi(zv.x), bflo(zv.y), bfhi(zv.y), bflo(zv.z), bfhi(zv.z), bflo(zv.w), bfhi(zv.w)};
      float s = 0.f;
#pragma unroll
      for (int i = 0; i < 8; i++) s += o[i];
#pragma unroll
      for (int k = 32; k > 0; k >>= 1) s += __shfl_xor(s, k);
      const float mu = s * (1.f / 512.f);
      float v = 0.f;
#pragma unroll
      for (int i = 0; i < 8; i++) { o[i] -= mu; v += o[i] * o[i]; }
#pragma unroll
      for (int k = 32; k > 0; k >>= 1) v += __shfl_xor(v, k);
      const float rs = rsqrtf(v * (1.f / 512.f) + 1e-6f);
      uint4 r;
      r.x = pack2(o[0] * rs * z[0], o[1] * rs * z[1]); r.y = pack2(o[2] * rs * z[2], o[3] * rs * z[3]);
      r.z = pack2(o[4] * rs * z[4], o[5] * rs * z[5]); r.w = pack2(o[6] * rs * z[6], o[7] * rs * z[7]);
      *(uint4*)(Z1 + off) = r;
    }
  }
  xcd_barrier(xb);
  TSTAMP(11);

  {
    PHASE_IDS
    const bf16_t* WO = (const bf16_t*)(ws + OFF_WOUT1T);
    const int xcd = bid & 7, lid = bid >> 3, nl = nb >> 3;
    for (int sq = lid; sq < 16 * 8; sq += nl) {
      int tml, tn; raster8(sq, 8, tml, tn);
      const int tm = xcd * 16 + tml;
      const int m0 = tm * 128, n0 = tn * 128;
      auto la = [&](int kt, int row, int ch) {
        return kt < 32 ? ld_bf(Z1, 2048, m0 + row, kt, ch) : ld_bf(EQ1, 256, m0 + row, kt - 32, ch);
      };
      auto lb = [&](int kt, int row, int ch) { return ld_bf(WO, 2304, n0 + row, kt, ch); };
      f32x4 acc[4][4]; zero_acc(acc);
      gemm_tile<4, 4, true>(acc, 36, la, lb, smem);
#pragma unroll
      for (int i = 0; i < 4; i++)
#pragma unroll
        for (int jj = 0; jj < 4; jj++) {
          if (jj == 0) __builtin_amdgcn_sched_barrier(0);
          const int m = m0 + wm * 64 + i * 16 + r16, n = n0 + wn * 64 + jj * 16 + quad * 4;
          const uint2 yv = *(const uint2*)(Y0 + (size_t)m * 1024 + n);
          float4 r;
          r.x = bflo(yv.x) + acc[i][jj][0]; r.y = bfhi(yv.x) + acc[i][jj][1];
          r.z = bflo(yv.y) + acc[i][jj][2]; r.w = bfhi(yv.y) + acc[i][jj][3];
          *(float4*)(p.out + (size_t)m * 1024 + n) = r;
        }
    }
  }
  xcd_barrier(xb);
  TSTAMP(12);

  {
    PHASE_IDS
    for (int t = gw; t < T; t += nw) {
      float4* xp = (float4*)(p.out + (size_t)t * 1024);
      float4 v[4]; float s = 0.f;
#pragma unroll
      for (int i = 0; i < 4; i++) { v[i] = xp[lane + i * 64]; s += v[i].x * v[i].x + v[i].y * v[i].y + v[i].z * v[i].z + v[i].w * v[i].w; }
#pragma unroll
      for (int o = 32; o > 0; o >>= 1) s += __shfl_xor(s, o);
      const float rs = rsqrtf(s * (1.f / 1024.f) + 1e-6f);
#pragma unroll
      for (int i = 0; i < 4; i++) {
        const float4 gg = ((const float4*)p.fin_g)[lane + i * 64];
        v[i].x *= rs * gg.x; v[i].y *= rs * gg.y; v[i].z *= rs * gg.z; v[i].w *= rs * gg.w;
        xp[lane + i * 64] = v[i];
      }
    }
  }
  if (TSA_MASK | TSB_MASK) {
    xcd_barrier(xb);
    TSTAMP(13);
    if (blockIdx.x == 0) {
      float a = 0.f, b = 0.f;
      for (int k = 0; k < 13; k++) {
        float d = (float)(TS[k + 1] - TS[k]) * 0.00001f;
        if ((TSA_MASK >> k) & 1) a += d;
        if ((TSB_MASK >> k) & 1) b += d;
      }
      if (threadIdx.x == 0) p.out[0] += a;
      for (int i = threadIdx.x; i < 1048576; i += 256) p.out[1024 + i] += 0.1f * b;
    }
  }
}

extern "C" void kernel_launch(void* const* d_in, const int* in_sizes, int n_in,
                              void* d_out, int out_size, void* d_ws, size_t ws_size,
                              hipStream_t stream) {
  static int grid_blocks = 0;
  if (!grid_blocks) {
    int dev = 0, cus = 0, per_cu = 0;
    (void)hipGetDevice(&dev);
    (void)hipDeviceGetAttribute(&cus, hipDeviceAttributeMultiprocessorCount, dev);
    (void)hipOccupancyMaxActiveBlocksPerMultiprocessor(&per_cu, fwd_megakernel, 256, 0);
    if (per_cu < 1) per_cu = 1;
    if (per_cu > 2) per_cu = 2;
    grid_blocks = cus * per_cu;
  }
  Params p{};
  p.x = (const float*)d_in[0]; p.mem = (const float*)d_in[1]; p.pos = (const int*)d_in[2];
  p.l0_g = (const float*)d_in[3]; p.l0_win = (const float*)d_in[4]; p.l0_gb = (const float*)d_in[5];
  p.pe_k = (const float*)d_in[6]; p.w1_k = (const float*)d_in[7]; p.w2_k = (const float*)d_in[8];
  p.pe_v = (const float*)d_in[9]; p.w1_v = (const float*)d_in[10]; p.w2_v = (const float*)d_in[11];
  p.l0_wmem = (const float*)d_in[12]; p.l0_wout = (const float*)d_in[13];
  p.l1_g = (const float*)d_in[14]; p.l1_win = (const float*)d_in[15]; p.l1_wmem = (const float*)d_in[16];
  p.l1_wout = (const float*)d_in[17]; p.mem_g = (const float*)d_in[18]; p.fin_g = (const float*)d_in[19];
  p.out = (float*)d_out; p.ws = (char*)d_ws;
  (void)hipMemsetAsync((char*)d_ws + OFF_XBAR, 0, XCD_BAR_WORDS * 4, stream);
  void* args[] = {&p};
  hipError_t e = hipLaunchCooperativeKernel((void*)fwd_megakernel, dim3(grid_blocks), dim3(256), args, 0, stream);
  if (e != hipSuccess) fprintf(stderr, "cooperative launch failed: %s (grid %d)\n", hipGetErrorString(e), grid_blocks);
}
```

```cpp
#include <hip/hip_runtime.h>
#include <hip/hip_cooperative_groups.h>
#include <cstdio>
namespace cg = cooperative_groups;

typedef unsigned short bf16_t;
typedef __attribute__((ext_vector_type(8))) short bf16x8;
typedef __attribute__((ext_vector_type(4))) short s16x4;
typedef __attribute__((ext_vector_type(4))) float f32x4;
#define DI __device__ __forceinline__
#define MFMA16(a, b, c) __builtin_amdgcn_mfma_f32_16x16x32_bf16((a), (b), (c), 0, 0, 0)

#ifndef DO_L0
#define DO_L0 1
#endif
#ifndef TSA_MASK
#define TSA_MASK 0
#endif
#ifndef TSB_MASK
#define TSB_MASK 0
#endif
#define TSTAMP(k) do { if ((TSA_MASK | TSB_MASK) && blockIdx.x == 0 && threadIdx.x == 0) TS[k] = wall_clock64(); } while (0)

constexpr int T = 16384;
constexpr int TP = 16384 + 64;
constexpr int LD0 = 4480;
constexpr int C_NQ = 0, C_KCI = 512, C_VCI = 640, C_KS = 768, C_VS = 896, C_KW = 1024, C_VW = 1152, C_NZ = 1280,
              C_MQ = 1792, C_MK = 2304, C_MV = 2816, C_MZ = 3328, C_EQ = 3840, C_EZ = 4096, C_NG = 4352;
constexpr float QSCALE = 0.125f * 1.4426950408889634f;
constexpr size_t Mi = 1048576;
constexpr size_t OFF_Y0 = 0;
constexpr size_t OFF_RSTD0 = 32 * Mi;
constexpr size_t OFF_RSTD1 = OFF_RSTD0 + 65536;
constexpr size_t OFF_MEMN = OFF_RSTD1 + 65536;
constexpr size_t OFF_MEMK0 = OFF_MEMN + 524288;
constexpr size_t OFF_MEMVT0 = OFF_MEMK0 + 131072;
constexpr size_t OFF_MEMK1 = OFF_MEMVT0 + 131072;
constexpr size_t OFF_MEMVT1 = OFF_MEMK1 + 131072;
constexpr size_t OFF_WMEM0T = 33 * Mi + 512 * 1024;
constexpr size_t OFF_WMEM1T = OFF_WMEM0T + Mi;
constexpr size_t RG = 36 * Mi;
constexpr size_t OFF_WT0 = RG;
constexpr size_t OFF_WOUT0T = RG + 9 * Mi;
constexpr size_t OFF_W1KT = RG + 12 * Mi;
constexpr size_t OFF_W1VT = OFF_W1KT + 262144;
constexpr size_t OFF_W2KT = OFF_W1VT + 262144;
constexpr size_t OFF_W2VT = OFF_W2KT + 8192;
constexpr size_t OFF_CBIAS = OFF_W2VT + 8192;
constexpr size_t OFF_KMEAN = OFF_CBIAS + 1024;
constexpr size_t OFF_KC = RG + 13 * Mi;
constexpr size_t OFF_VCT = OFF_KC + 262144;
constexpr size_t OFF_HID = OFF_VCT + 262144;
constexpr size_t OFF_ROPE0C = RG + 14 * Mi;
constexpr size_t OFF_ROPE0S = RG + 16 * Mi;
constexpr size_t OFF_NG = RG + 18 * Mi;
constexpr size_t OFF_VST = RG + 20 * Mi;
constexpr size_t OFF_VWT = RG + 25 * Mi;
constexpr size_t OFF_MVT = RG + 30 * Mi;
constexpr size_t OFF_PR0 = RG + 47 * Mi;
constexpr size_t OFF_WRZT = RG;
constexpr size_t OFF_WOUT1T = RG + 4 * Mi;
constexpr size_t OFF_EQ1 = RG + 9 * Mi;
constexpr size_t OFF_EZ1 = RG + 17 * Mi;
constexpr size_t OFF_KP = RG + 25 * Mi;
constexpr size_t OFF_KPT = RG + 57 * Mi;
constexpr size_t OFF_O = OFF_KP;
constexpr size_t OFF_VT = RG + 89 * Mi + 512 * 1024;
constexpr size_t OFF_Z = OFF_VT;
constexpr size_t OFF_S = RG + 154 * Mi + 512 * 1024;
constexpr size_t OFF_ROPE1C = OFF_S;
constexpr size_t OFF_ROPE1S = OFF_S + 8 * Mi;
constexpr size_t OFF_WT1 = OFF_S + 16 * Mi;
constexpr size_t OFF_XB1 = OFF_S + 25 * Mi;
constexpr size_t OFF_XB0 = 0;
constexpr size_t OFF_PARTA = 223 * Mi;
constexpr size_t OFF_PARTB = 0;
constexpr size_t PART_HEAD = 6 * Mi;
constexpr size_t OFF_LSESEL = 253 * Mi;
constexpr size_t OFF_LSEOWN = 253 * Mi + 1536 * 1024;
constexpr size_t OFF_CNT = 33 * Mi + 262144 + 1024;
constexpr size_t OFF_XBAR = 33 * Mi + 262144 + 16384;
constexpr size_t DOFF_BUCKET = 40 * Mi;
constexpr int BUCKET_HEAD = 516096;
constexpr size_t DOFF_P = 32 * Mi;

struct Params {
  const float* x; const float* mem; const int* pos;
  const float *l0_g, *l0_win, *l0_gb, *pe_k, *w1_k, *w2_k, *pe_v, *w1_v, *w2_v, *l0_wmem, *l0_wout;
  const float *l1_g, *l1_win, *l1_wmem, *l1_wout, *mem_g, *fin_g;
  float* out; char* ws;
};

DI bf16_t f2bf(float f) { unsigned u = __float_as_uint(f); u += 0x7fffu + ((u >> 16) & 1u); return (bf16_t)(u >> 16); }
DI float bf2f(bf16_t h) { return __uint_as_float(((unsigned)h) << 16); }
typedef __bf16 bf2_t __attribute__((ext_vector_type(2)));
typedef float f2_t __attribute__((ext_vector_type(2)));
DI unsigned pack2(float a, float b) { f2_t v = {a, b}; bf2_t r = __builtin_convertvector(v, bf2_t); return __builtin_bit_cast(unsigned, r); }
DI float bflo(unsigned u) { return __uint_as_float(u << 16); }
DI float bfhi(unsigned u) { return __uint_as_float(u & 0xffff0000u); }
DI float silu_f(float x) { return x / (1.f + __expf(-x)); }
DI float sigm_f(float x) { return 1.f / (1.f + __expf(-x)); }
DI float ex2(float x) { return __builtin_amdgcn_exp2f(x); }
DI void wave_lds_sync() { asm volatile("s_waitcnt lgkmcnt(0)" ::: "memory"); }
DI uint2 pack4(f32x4 v) { uint2 r; r.x = pack2(v[0], v[1]); r.y = pack2(v[2], v[3]); return r; }

template <int WM, int WN, bool SWAP, bool PERMB = false, class LA, class LB>
DI void gemm_tile(f32x4 (&acc)[WM][WN], int nk, LA loadA, LB loadB, bf16_t* smem) {
  constexpr int BM = WM * 32, BN = WN * 32, LD = 80, NA = BM / 32, NB = BN / 32;
  bf16_t* sA = smem;
  bf16_t* sB = smem + 2 * BM * LD;
  int tid = threadIdx.x;
  asm volatile("" : "+v"(tid));
  const int lane = tid & 63, wave = tid >> 6, wm = wave >> 1, wn = wave & 1;
  const int r16 = lane & 15, quad = lane >> 4;
  uint4 ra0[NA], rb0[NB], ra1[NA], rb1[NB];
#define GT_LOAD(RA, RB, KT)                                                                          \
  {                                                                                                  \
    _Pragma("unroll") for (int i = 0; i < NA; i++) { int idx = tid + i * 256; RA[i] = loadA((KT), idx >> 3, idx & 7); } \
    _Pragma("unroll") for (int i = 0; i < NB; i++) { int idx = tid + i * 256; RB[i] = loadB((KT), idx >> 3, idx & 7); } \
    __builtin_amdgcn_sched_barrier(0);                                                               \
  }
#define GT_STORE(RA, RB, BUF)                                                                        \
  {                                                                                                  \
    __builtin_amdgcn_sched_barrier(0);                                                               \
    bf16_t* sAn = sA + (BUF) * BM * LD; bf16_t* sBn = sB + (BUF) * BN * LD;                           \
    _Pragma("unroll") for (int i = 0; i < NA; i++) { int idx = tid + i * 256; *(uint4*)(sAn + (idx >> 3) * LD + (idx & 7) * 8) = RA[i]; } \
    _Pragma("unroll") for (int i = 0; i < NB; i++) { int idx = tid + i * 256; int rw = idx >> 3;                             \
      if (PERMB) rw = (rw & ~63) | (((rw >> 2) & 3) << 4) | (((rw >> 4) & 3) << 2) | (rw & 3);                               \
      *(uint4*)(sBn + rw * LD + (idx & 7) * 8) = RB[i]; } \
  }
#define GT_COMPUTE(BUF)                                                                              \
  {                                                                                                  \
    const bf16_t* ab = sA + (BUF) * BM * LD + (wm * WM * 16 + r16) * LD + quad * 8;                   \
    const bf16_t* bb = sB + (BUF) * BN * LD + (wn * WN * 16 + r16) * LD + quad * 8;                   \
    _Pragma("unroll") for (int kk = 0; kk < 2; kk++) {                                               \
      bf16x8 af[WM], bfr[WN];                                                                        \
      _Pragma("unroll") for (int i = 0; i < WM; i++) af[i] = *(const bf16x8*)(ab + i * 16 * LD + kk * 32);  \
      _Pragma("unroll") for (int j = 0; j < WN; j++) bfr[j] = *(const bf16x8*)(bb + j * 16 * LD + kk * 32); \
      _Pragma("unroll") for (int i = 0; i < WM; i++)                                                 \
        _Pragma("unroll") for (int j = 0; j < WN; j++)                                               \
          acc[i][j] = SWAP ? MFMA16(bfr[j], af[i], acc[i][j]) : MFMA16(af[i], bfr[j], acc[i][j]);    \
    }                                                                                                \
  }
  GT_LOAD(ra0, rb0, 0);
  if (nk > 1) GT_LOAD(ra1, rb1, 1);
  GT_STORE(ra0, rb0, 0);
  __syncthreads();
  for (int kt = 0; kt < nk; kt += 2) {
    if (kt + 2 < nk) GT_LOAD(ra0, rb0, kt + 2);
    GT_COMPUTE(0);
    if (kt + 1 < nk) GT_STORE(ra1, rb1, 1);
    __syncthreads();
    if (kt + 1 >= nk) break;
    if (kt + 3 < nk) GT_LOAD(ra1, rb1, kt + 3);
    GT_COMPUTE(1);
    if (kt + 2 < nk) GT_STORE(ra0, rb0, 0);
    __syncthreads();
  }
#undef GT_LOAD
#undef GT_STORE
#undef GT_COMPUTE
}

template <int WM, int WN>
DI void zero_acc(f32x4 (&acc)[WM][WN]) {
#pragma unroll
  for (int i = 0; i < WM; i++)
#pragma unroll
    for (int j = 0; j < WN; j++) acc[i][j] = (f32x4){0.f, 0.f, 0.f, 0.f};
}

DI uint4 ld_bf(const bf16_t* base, size_t ld, int row, int kt, int ch) {
  return *(const uint4*)(base + (size_t)row * ld + kt * 64 + ch * 8);
}
DI uint4 ld_x(const float* x, const bf16_t* y0, int t, int kt, int ch) {
  const int k = kt * 64 + ch * 8;
  const float4* xp = (const float4*)(x + (size_t)t * 1024 + k);
  float4 a = xp[0], b = xp[1];
  if (y0) {
    uint4 yv = *(const uint4*)(y0 + (size_t)t * 1024 + k);
    a.x += bflo(yv.x); a.y += bfhi(yv.x); a.z += bflo(yv.y); a.w += bfhi(yv.y);
    b.x += bflo(yv.z); b.y += bfhi(yv.z); b.z += bflo(yv.w); b.w += bfhi(yv.w);
  }
  uint4 r;
  r.x = pack2(a.x, a.y); r.y = pack2(a.z, a.w); r.z = pack2(b.x, b.y); r.w = pack2(b.z, b.w);
  return r;
}

template <class CM>
DI void transpose_w(const float* src, int K, int srcN, bf16_t* dst, int Npad, CM cm, float* sm, int bid, int nb, const float* gk = nullptr) {
  int tid = threadIdx.x;
  asm volatile("" : "+v"(tid));
  const int tx = tid & 63, ty = tid >> 6;
  const int tilesK = K / 64, tilesN = Npad / 64;
  for (int it = bid; it < tilesK * tilesN; it += nb) {
    const int n0 = (it / tilesK) * 64, k0 = (it % tilesK) * 64;
    const int sc = cm(n0 + tx);
#pragma unroll 4
    for (int i = 0; i < 16; i++) {
      int kk = ty + i * 4;
      sm[kk * 65 + tx] = sc >= 0 ? src[(size_t)(k0 + kk) * srcN + sc] : 0.f;
    }
    __syncthreads();
#pragma unroll 4
    for (int i = 0; i < 16; i++) {
      int nn = ty + i * 4;
      dst[(size_t)(n0 + nn) * K + k0 + tx] = f2bf(sm[tx * 65 + nn] * (gk ? gk[k0 + tx] : 1.f));
    }
    __syncthreads();
  }
}

DI void row_rstd(const float* x, const bf16_t* y0, float* rstd, bf16_t* xb, int rows, int gw, int nw, int lane) {
  for (int t = gw; t < rows; t += nw) {
    const float4* xp = (const float4*)(x + (size_t)t * 1024);
    float s = 0.f;
#pragma unroll
    for (int i = 0; i < 4; i++) {
      float4 v = xp[lane + i * 64];
      if (y0) {
        uint2 yv = *(const uint2*)(y0 + (size_t)t * 1024 + (lane + i * 64) * 4);
        v.x += bflo(yv.x); v.y += bfhi(yv.x); v.z += bflo(yv.y); v.w += bfhi(yv.y);
      }
      s += v.x * v.x + v.y * v.y + v.z * v.z + v.w * v.w;
      uint2 o; o.x = pack2(v.x, v.y); o.y = pack2(v.z, v.w);
      *(uint2*)(xb + (size_t)t * 1024 + (lane + i * 64) * 4) = o;
    }
#pragma unroll
    for (int o = 32; o > 0; o >>= 1) s += __shfl_xor(s, o);
    if (lane == 0) rstd[t] = rsqrtf(s * (1.f / 1024.f) + 1e-6f);
  }
}

struct AttnSt { float m, l; f32x4 o[4]; };
DI void attn_init(AttnSt& s) {
  s.m = -1e30f; s.l = 0.f;
#pragma unroll
  for (int i = 0; i < 4; i++) s.o[i] = (f32x4){0.f, 0.f, 0.f, 0.f};
}
DI f32x4 qk16(const bf16_t* K, int ks, int key0, bf16x8 q0, bf16x8 q1, int lane) {
  const bf16_t* kp = K + (size_t)(key0 + (lane & 15)) * ks + (lane >> 4) * 8;
  bf16x8 k0 = *(const bf16x8*)kp;
  bf16x8 k1 = *(const bf16x8*)(kp + 32);
  f32x4 s = {0.f, 0.f, 0.f, 0.f};
  s = MFMA16(k0, q0, s);
  s = MFMA16(k1, q1, s);
  return s;
}
DI f32x4 qk16p(const bf16_t* K, int ks, int key0, int half, bf16x8 q0, bf16x8 q1, int lane) {
  const int r16 = lane & 15;
  const bf16_t* kp = K + (size_t)(key0 + (r16 >> 2) * 8 + (r16 & 3) + half * 4) * ks + (lane >> 4) * 8;
  bf16x8 k0 = *(const bf16x8*)kp;
  bf16x8 k1 = *(const bf16x8*)(kp + 32);
  f32x4 s = {0.f, 0.f, 0.f, 0.f};
  s = MFMA16(k0, q0, s);
  s = MFMA16(k1, q1, s);
  return s;
}
template <class MF>
DI void attn_step(const bf16_t* K, int ks, const bf16_t* Vt, int vs, int key0, bf16x8 q0, bf16x8 q1, AttnSt& st,
                  MF maskf, int lane) {
  const int r16 = lane & 15, quad = lane >> 4;
  f32x4 sa = qk16p(K, ks, key0, 0, q0, q1, lane);
  f32x4 sb = qk16p(K, ks, key0, 1, q0, q1, lane);
  const bf16_t* vp = Vt + (size_t)r16 * vs + key0 + quad * 8;
  bf16x8 vf[4];
#pragma unroll
  for (int dt = 0; dt < 4; dt++) vf[dt] = *(const bf16x8*)(vp + (size_t)dt * 16 * vs);
  bool ma[4], mb[4];
  float lm = -1e30f;
#pragma unroll
  for (int r = 0; r < 4; r++) {
    ma[r] = maskf(key0 + quad * 8 + r);
    mb[r] = maskf(key0 + quad * 8 + 4 + r);
    if (ma[r]) lm = fmaxf(lm, sa[r]);
    if (mb[r]) lm = fmaxf(lm, sb[r]);
  }
  if (__ballot(lm > st.m + 8.f) != 0ull) {
    float mx = fmaxf(lm, __shfl_xor(lm, 16));
    mx = fmaxf(mx, __shfl_xor(mx, 32));
    const float mn = (mx > st.m + 8.f) ? mx : st.m;
    const float alpha = ex2(st.m - mn);
    st.l *= alpha;
    st.m = mn;
#pragma unroll
    for (int dt = 0; dt < 4; dt++) st.o[dt] *= alpha;
  }
  float pa[4], pb[4], rs = 0.f;
#pragma unroll
  for (int r = 0; r < 4; r++) {
    pa[r] = ma[r] ? ex2(sa[r] - st.m) : 0.f;
    pb[r] = mb[r] ? ex2(sb[r] - st.m) : 0.f;
    rs += pa[r] + pb[r];
  }
  st.l += rs;
  uint4 pu;
  pu.x = pack2(pa[0], pa[1]); pu.y = pack2(pa[2], pa[3]); pu.z = pack2(pb[0], pb[1]); pu.w = pack2(pb[2], pb[3]);
  const bf16x8 pf = __builtin_bit_cast(bf16x8, pu);
#pragma unroll
  for (int dt = 0; dt < 4; dt++) st.o[dt] = MFMA16(vf[dt], pf, st.o[dt]);
}
template <class MF>
DI void attn_compute64(const bf16x8 (&kf)[8], const bf16x8 (&vf)[8], int key0, bf16x8 q0, bf16x8 q1, AttnSt& st, MF maskf, int lane) {
  const int quad = lane >> 4;
  f32x4 sc4[4];
#pragma unroll
  for (int j = 0; j < 4; j++) {
    f32x4 z = {0.f, 0.f, 0.f, 0.f};
    z = MFMA16(kf[(j >> 1) * 4 + (j & 1) * 2 + 0], q0, z);
    sc4[j] = MFMA16(kf[(j >> 1) * 4 + (j & 1) * 2 + 1], q1, z);
  }
  bool mk[4][4];
  float lm = -1e30f;
#pragma unroll
  for (int j = 0; j < 4; j++)
#pragma unroll
    for (int r = 0; r < 4; r++) {
      mk[j][r] = maskf(key0 + (j >> 1) * 32 + quad * 8 + (j & 1) * 4 + r);
      if (mk[j][r]) lm = fmaxf(lm, sc4[j][r]);
    }
  if (__ballot(lm > st.m + 8.f) != 0ull) {
    float mx = fmaxf(lm, __shfl_xor(lm, 16));
    mx = fmaxf(mx, __shfl_xor(mx, 32));
    const float mn = (mx > st.m + 8.f) ? mx : st.m;
    const float alpha = ex2(st.m - mn);
    st.l *= alpha;
    st.m = mn;
#pragma unroll
    for (int dt = 0; dt < 4; dt++) st.o[dt] *= alpha;
  }
  float pv[4][4], rs = 0.f;
#pragma unroll
  for (int j = 0; j < 4; j++)
#pragma unroll
    for (int r = 0; r < 4; r++) { pv[j][r] = mk[j][r] ? ex2(sc4[j][r] - st.m) : 0.f; rs += pv[j][r]; }
  st.l += rs;
#pragma unroll
  for (int hb = 0; hb < 2; hb++) {
    uint4 pu;
    pu.x = pack2(pv[hb * 2][0], pv[hb * 2][1]); pu.y = pack2(pv[hb * 2][2], pv[hb * 2][3]);
    pu.z = pack2(pv[hb * 2 + 1][0], pv[hb * 2 + 1][1]); pu.w = pack2(pv[hb * 2 + 1][2], pv[hb * 2 + 1][3]);
    const bf16x8 pf = __builtin_bit_cast(bf16x8, pu);
#pragma unroll
    for (int dt = 0; dt < 4; dt++) st.o[dt] = MFMA16(vf[hb * 4 + dt], pf, st.o[dt]);
  }
}
template <class MF>
DI void attn_step64(const bf16_t* K, int ks, const bf16_t* Vt, int vs, int key0, bf16x8 q0, bf16x8 q1, AttnSt& st,
                    MF maskf, int lane) {
  const int r16 = lane & 15, quad = lane >> 4;
  const bf16_t* kp = K + (size_t)(key0 + (r16 >> 2) * 8 + (r16 & 3)) * ks + quad * 8;
  bf16x8 kf[8];
#pragma unroll
  for (int hb = 0; hb < 2; hb++) {
    const bf16_t* kq = kp + (size_t)hb * 32 * ks;
    kf[hb * 4 + 0] = *(const bf16x8*)kq; kf[hb * 4 + 1] = *(const bf16x8*)(kq + 32);
    kf[hb * 4 + 2] = *(const bf16x8*)(kq + (size_t)4 * ks); kf[hb * 4 + 3] = *(const bf16x8*)(kq + (size_t)4 * ks + 32);
  }
  const bf16_t* vp = Vt + (size_t)r16 * vs + key0 + quad * 8;
  bf16x8 vf[8];
#pragma unroll
  for (int dt = 0; dt < 4; dt++) { vf[dt] = *(const bf16x8*)(vp + (size_t)dt * 16 * vs); vf[4 + dt] = *(const bf16x8*)(vp + (size_t)dt * 16 * vs + 32); }
  attn_compute64(kf, vf, key0, q0, q1, st, maskf, lane);
}
template <class MF>
DI void attn_block_lds(const bf16_t* K, int ks, const bf16_t* Vt, int vs, int key0, bf16x8 q0, bf16x8 q1, AttnSt& st,
                       MF maskf, char* stage, int lane) {
  const int r16 = lane & 15, quad = lane >> 4;
  const int rsub = lane >> 3, ch = lane & 7;
  {
    uint4 tk[8];
#pragma unroll
    for (int i = 0; i < 8; i++) tk[i] = *(const uint4*)(K + (size_t)(key0 + i * 8 + rsub) * ks + ch * 8);
    uint4 tv[4];
#pragma unroll
    for (int i = 0; i < 4; i++) tv[i] = *(const uint4*)(Vt + (size_t)(i * 8 + rsub) * vs + key0 + ch * 8);
#pragma unroll
    for (int i = 0; i < 8; i++) *(uint4*)(stage + (i * 8 + rsub) * 144 + ch * 16) = tk[i];
#pragma unroll
    for (int i = 0; i < 4; i++) tk[i] = *(const uint4*)(Vt + (size_t)((i + 4) * 8 + rsub) * vs + key0 + ch * 8);
#pragma unroll
    for (int i = 0; i < 4; i++) *(uint4*)(stage + 9216 + (i * 8 + rsub) * 144 + ch * 16) = tv[i];
#pragma unroll
    for (int i = 0; i < 4; i++) *(uint4*)(stage + 9216 + ((i + 4) * 8 + rsub) * 144 + ch * 16) = tk[i];
  }
  wave_lds_sync();
  bf16x8 kf[8], vf[8];
  const char* kb = stage + ((r16 >> 2) * 8 + (r16 & 3)) * 144 + quad * 16;
#pragma unroll
  for (int hb = 0; hb < 2; hb++) {
    kf[hb * 4 + 0] = *(const bf16x8*)(kb + hb * 32 * 144);
    kf[hb * 4 + 1] = *(const bf16x8*)(kb + hb * 32 * 144 + 64);
    kf[hb * 4 + 2] = *(const bf16x8*)(kb + (hb * 32 + 4) * 144);
    kf[hb * 4 + 3] = *(const bf16x8*)(kb + (hb * 32 + 4) * 144 + 64);
  }
  const char* vb = stage + 9216 + r16 * 144 + quad * 16;
#pragma unroll
  for (int dt = 0; dt < 4; dt++) { vf[dt] = *(const bf16x8*)(vb + dt * 16 * 144); vf[4 + dt] = *(const bf16x8*)(vb + dt * 16 * 144 + 64); }
  wave_lds_sync();
  attn_compute64(kf, vf, key0, q0, q1, st, maskf, lane);
}
DI void attn_finish(AttnSt& st) {
  st.l += __shfl_xor(st.l, 16);
  st.l += __shfl_xor(st.l, 32);
}
DI void load_q(const bf16_t* qrow, int lane, bf16x8& q0, bf16x8& q1) {
  q0 = *(const bf16x8*)(qrow + (lane >> 4) * 8);
  q1 = *(const bf16x8*)(qrow + 32 + (lane >> 4) * 8);
}

DI void mem_attn_item(const bf16_t* qsrc, int qld, const bf16_t* zsrc, int zld, bf16_t* dst, int dld,
                      const bf16_t* memK, const bf16_t* memVT, int t0, int h, int lane, char* stage) {
  const int r16 = lane & 15, quad = lane >> 4;
  const int t = t0 + r16;
  bf16x8 q0, q1;
  load_q(qsrc + (size_t)t * qld + h * 64, lane, q0, q1);
  AttnSt st; attn_init(st);
  for (int key0 = 0; key0 < 256; key0 += 64)
    attn_block_lds(memK + h * 64, 256, memVT + (size_t)h * 64 * 256, 256, key0, q0, q1, st, [](int) { return true; }, stage, lane);
  attn_finish(st);
  const float inv = 1.f / fmaxf(st.l, 1e-30f);
#pragma unroll
  for (int dt = 0; dt < 4; dt++) {
    const int d = dt * 16 + quad * 4;
    uint2 zv = *(const uint2*)(zsrc + (size_t)t * zld + h * 64 + d);
    f32x4 o = st.o[dt];
    uint2 r;
    r.x = pack2(o[0] * inv * bflo(zv.x), o[1] * inv * bfhi(zv.x));
    r.y = pack2(o[2] * inv * bflo(zv.y), o[3] * inv * bfhi(zv.y));
    *(uint2*)(dst + (size_t)t * dld + h * 64 + d) = r;
  }
}

DI void moba_item(const bf16_t* PR0, const bf16_t* MVT, const bf16_t* KMEAN, bf16_t* CAT0, int* CNT, int* BUCKET,
                  float* LSESEL, float* LSEOWN, int t0, int h, int lane, char* stage) {
  const int r16 = lane & 15, quad = lane >> 4;
  const int t = t0 + r16;
  const int cur = t0 >> 8;
  bf16x8 q0, q1;
  load_q(PR0 + (size_t)t * LD0 + C_MQ + h * 64, lane, q0, q1);
  unsigned long long k1 = 0, k2 = 0, k3 = 0;
  auto ins = [&](unsigned long long k) {
    unsigned long long a = k1 > k ? k1 : k, r = k1 > k ? k : k1;
    k1 = a;
    a = k2 > r ? k2 : r; r = k2 > r ? r : k2;
    k2 = a;
    k3 = k3 > r ? k3 : r;
  };
  if (cur > 0) {
#pragma unroll
    for (int kt = 0; kt < 4; kt++) {
      f32x4 s = qk16(KMEAN + h * 64, 512, kt * 16, q0, q1, lane);
#pragma unroll
      for (int r = 0; r < 4; r++) {
        const int n = kt * 16 + quad * 4 + r;
        unsigned u = __float_as_uint(s[r]);
        u = (u & 0x80000000u) ? ~u : (u | 0x80000000u);
        unsigned long long key = (((unsigned long long)u) << 8) | (unsigned)(63 - n);
        if (n < cur) ins(key);
      }
    }
#pragma unroll
    for (int off = 16; off <= 32; off <<= 1) {
      unsigned long long o1, o2, o3;
      o1 = ((unsigned long long)__shfl_xor((unsigned)(k1 >> 32), off) << 32) | __shfl_xor((unsigned)k1, off);
      o2 = ((unsigned long long)__shfl_xor((unsigned)(k2 >> 32), off) << 32) | __shfl_xor((unsigned)k2, off);
      o3 = ((unsigned long long)__shfl_xor((unsigned)(k3 >> 32), off) << 32) | __shfl_xor((unsigned)k3, off);
      ins(o1); ins(o2); ins(o3);
    }
  }
  if (quad == 0) {
#pragma unroll
    for (int k = 0; k < 3; k++) {
      const unsigned long long kk = k == 0 ? k1 : (k == 1 ? k2 : k3);
      if (kk) {
        const int n = 63 - (int)(kk & 0xff);
        const int slot = atomicAdd(CNT + h * 64 + n, 1);
        BUCKET[(size_t)h * BUCKET_HEAD + n * T - 128 * n * (n + 1) + slot] = (t << 2) | k;
      } else {
        LSESEL[((size_t)t * 8 + h) * 3 + k] = -1e30f;
      }
    }
  }
  AttnSt st; attn_init(st);
  const bf16_t* Kb = PR0 + C_MK + h * 64;
  const bf16_t* Vb = MVT + (size_t)h * 64 * TP;
  for (int key0 = cur * 256; key0 <= t0 + 15; key0 += 64)
    attn_block_lds(Kb, LD0, Vb, TP, key0, q0, q1, st, [&](int key) { return key <= t; }, stage, lane);
  attn_finish(st);
  const float inv = 1.f / fmaxf(st.l, 1e-30f);
#pragma unroll
  for (int dt = 0; dt < 4; dt++) {
    const int d = dt * 16 + quad * 4;
    *(uint2*)(CAT0 + (size_t)t * 1280 + 512 + h * 64 + d) = pack4(st.o[dt] * inv);
  }
  if (quad == 0) LSEOWN[(size_t)t * 8 + h] = st.m + log2f(fmaxf(st.l, 1e-30f));
}

DI void moba_bucket_item(const bf16_t* PR0, const bf16_t* MVT, const int* BUCKET, char* ws, float* LSESEL,
                         int h, int n, int e0, int count, int lane) {
  const int r16 = lane & 15, quad = lane >> 4;
  const int* bk = BUCKET + (size_t)h * BUCKET_HEAD + n * T - 128 * n * (n + 1);
  bf16x8 q0[4], q1[4];
  int ent[4];
  AttnSt st[4];
#pragma unroll
  for (int ct = 0; ct < 4; ct++) {
    const int e = e0 + ct * 16 + r16;
    ent[ct] = e < count ? bk[e] : -1;
    const int t = ent[ct] >= 0 ? (ent[ct] >> 2) : 0;
    load_q(PR0 + (size_t)t * LD0 + C_MQ + h * 64, lane, q0[ct], q1[ct]);
    attn_init(st[ct]);
  }
  const bf16_t* Kb = PR0 + C_MK + h * 64;
  const bf16_t* Vb = MVT + (size_t)h * 64 * TP;
  for (int key0 = n * 256; key0 < n * 256 + 256; key0 += 32) {
    const bf16_t* kp = Kb + (size_t)(key0 + (r16 >> 2) * 8 + (r16 & 3)) * LD0 + quad * 8;
    const bf16x8 ka0 = *(const bf16x8*)kp, ka1 = *(const bf16x8*)(kp + 32);
    const bf16x8 kb0 = *(const bf16x8*)(kp + (size_t)4 * LD0), kb1 = *(const bf16x8*)(kp + (size_t)4 * LD0 + 32);
    const bf16_t* vp = Vb + (size_t)r16 * TP + key0 + quad * 8;
    bf16x8 vf[4];
#pragma unroll
    for (int dt = 0; dt < 4; dt++) vf[dt] = *(const bf16x8*)(vp + (size_t)dt * 16 * TP);
#pragma unroll
    for (int ct = 0; ct < 4; ct++) {
      f32x4 sa = {0.f, 0.f, 0.f, 0.f}, sb = {0.f, 0.f, 0.f, 0.f};
      sa = MFMA16(ka0, q0[ct], sa); sa = MFMA16(ka1, q1[ct], sa);
      sb = MFMA16(kb0, q0[ct], sb); sb = MFMA16(kb1, q1[ct], sb);
      const float lm = fmaxf(fmaxf(fmaxf(sa[0], sa[1]), fmaxf(sa[2], sa[3])), fmaxf(fmaxf(sb[0], sb[1]), fmaxf(sb[2], sb[3])));
      if (__ballot(lm > st[ct].m + 8.f) != 0ull) {
        float mx = fmaxf(lm, __shfl_xor(lm, 16));
        mx = fmaxf(mx, __shfl_xor(mx, 32));
        const float mn = (mx > st[ct].m + 8.f) ? mx : st[ct].m;
        const float alpha = ex2(st[ct].m - mn);
        st[ct].l *= alpha;
        st[ct].m = mn;
#pragma unroll
        for (int dt = 0; dt < 4; dt++) st[ct].o[dt] *= alpha;
      }
      f32x4 pa, pb;
#pragma unroll
      for (int r = 0; r < 4; r++) { pa[r] = ex2(sa[r] - st[ct].m); pb[r] = ex2(sb[r] - st[ct].m); }
      st[ct].l += (pa[0] + pa[1]) + (pa[2] + pa[3]) + (pb[0] + pb[1]) + (pb[2] + pb[3]);
      uint4 pu;
      pu.x = pack2(pa[0], pa[1]); pu.y = pack2(pa[2], pa[3]); pu.z = pack2(pb[0], pb[1]); pu.w = pack2(pb[2], pb[3]);
      const bf16x8 pf = __builtin_bit_cast(bf16x8, pu);
#pragma unroll
      for (int dt = 0; dt < 4; dt++) st[ct].o[dt] = MFMA16(vf[dt], pf, st[ct].o[dt]);
    }
  }
#pragma unroll
  for (int ct = 0; ct < 4; ct++) attn_finish(st[ct]);
  bf16_t* part = (bf16_t*)(ws + (h < 5 ? OFF_PARTA + (size_t)h * PART_HEAD : OFF_PARTB + (size_t)(h - 5) * PART_HEAD));
#pragma unroll
  for (int ct = 0; ct < 4; ct++) {
    if (ent[ct] < 0) continue;
    const int t = ent[ct] >> 2, k = ent[ct] & 3;
    const float inv = 1.f / fmaxf(st[ct].l, 1e-30f);
#pragma unroll
    for (int dt = 0; dt < 4; dt++)
      *(uint2*)(part + ((size_t)t * 3 + k) * 64 + dt * 16 + quad * 4) = pack4(st[ct].o[dt] * inv);
    if (quad == 0) LSESEL[((size_t)t * 8 + h) * 3 + k] = st[ct].m + log2f(fmaxf(st[ct].l, 1e-30f));
  }
}

DI void nsa_item(const bf16_t* PR0, const bf16_t* KC, const bf16_t* VCT, const bf16_t* VST, const bf16_t* VWT,
                 const float* NG, bf16_t* CAT0, int t0, int g, float* impw, unsigned* selw, int lane) {
  char* stage = (char*)impw;
  const int r16 = lane & 15, quad = lane >> 4;
  const int ql = r16 >> 2, hd = r16 & 3, H = g * 4 + hd;
  const int t = t0 + ql;
  const int cur = t0 >> 6;
  bf16x8 q0, q1;
  load_q(PR0 + (size_t)t * LD0 + C_NQ + H * 64, lane, q0, q1);
  const int nmax = (t >= 31) ? ((t - 31) >> 4) : -1;
  const int nmax_tile = (t0 + 3 >= 31) ? ((t0 + 3 - 31) >> 4) : -1;
  const bf16_t* Kc = KC + g * 64;
  const bf16_t* Vc = VCT + (size_t)g * 64 * 1024;
  AttnSt sc; attn_init(sc);
  for (int key0 = 0; key0 <= nmax_tile; key0 += 64)
    attn_block_lds(Kc, 128, Vc, 1024, key0, q0, q1, sc, [&](int n) { return n <= nmax; }, stage, lane);
  attn_finish(sc);
  if (cur >= 3) {
    const float invl = 1.f / fmaxf(sc.l, 1e-30f);
    float carry = 0.f;
    char* kst = stage + 9216;
    for (int key0 = 0; key0 <= nmax_tile; key0 += 32) {
      if ((key0 & 32) == 0) {
        wave_lds_sync();
        const int rsub = lane >> 3, ch = lane & 7;
        uint4 tk[8];
#pragma unroll
        for (int i = 0; i < 8; i++) tk[i] = *(const uint4*)(Kc + (size_t)(key0 + i * 8 + rsub) * 128 + ch * 8);
#pragma unroll
        for (int i = 0; i < 8; i++) *(uint4*)(kst + (i * 8 + rsub) * 144 + ch * 16) = tk[i];
        wave_lds_sync();
      }
      const char* kp = kst + ((key0 & 32) + (r16 >> 2) * 8 + (r16 & 3)) * 144 + quad * 16;
      f32x4 sa = {0.f, 0.f, 0.f, 0.f}, sb = {0.f, 0.f, 0.f, 0.f};
      sa = MFMA16(*(const bf16x8*)kp, q0, sa); sa = MFMA16(*(const bf16x8*)(kp + 64), q1, sa);
      sb = MFMA16(*(const bf16x8*)(kp + 4 * 144), q0, sb); sb = MFMA16(*(const bf16x8*)(kp + 4 * 144 + 64), q1, sb);
      float xa = 0.f, xb = 0.f, ea = 0.f, eb = 0.f;
#pragma unroll
      for (int r = 0; r < 4; r++) {
        float pa = (key0 + quad * 8 + r <= nmax) ? ex2(sa[r] - sc.m) * invl : 0.f;
        float pb = (key0 + quad * 8 + 4 + r <= nmax) ? ex2(sb[r] - sc.m) * invl : 0.f;
        xa += pa; xb += pb;
        if (r == 3) { ea = pa; eb = pb; }
      }
      const float eb_up = __shfl(eb, (lane - 16) & 63);
      const float eb_q3 = __shfl(eb, r16 + 48);
      float ia = xa + (quad > 0 ? eb_up : carry);
      float ib = xb + ea;
      carry = eb_q3;
      ia += __shfl_xor(ia, 1); ia += __shfl_xor(ia, 2);
      ib += __shfl_xor(ib, 1); ib += __shfl_xor(ib, 2);
      if (hd == 0) {
        impw[ql * 256 + (key0 >> 2) + 2 * quad] = ia;
        impw[ql * 256 + (key0 >> 2) + 2 * quad + 1] = ib;
      }
    }
  }
  wave_lds_sync();
  {
    const int nforced = cur == 0 ? 1 : (cur == 1 ? 2 : 3);
    const int R = 16 - nforced;
    const int hi = cur - 2;
    const int cnt = hi >= 1 ? hi : 0;
    const int sb = lane * 4;
    f32x4 vq[4];
    unsigned nib[4];
#pragma unroll
    for (int qq = 0; qq < 4; qq++) {
      vq[qq] = (f32x4){-1.f, -1.f, -1.f, -1.f};
      nib[qq] = 0u;
      if (cnt > 0) {
        const f32x4 iv = *(const f32x4*)(impw + qq * 256 + sb);
#pragma unroll
        for (int i = 0; i < 4; i++) if (sb + i >= 1 && sb + i <= hi) vq[qq][i] = iv[i];
      }
    }
    if (cnt <= R) {
#pragma unroll
      for (int qq = 0; qq < 4; qq++)
        nib[qq] = (vq[qq][0] >= 0.f ? 1u : 0u) | (vq[qq][1] >= 0.f ? 2u : 0u) | (vq[qq][2] >= 0.f ? 4u : 0u) | (vq[qq][3] >= 0.f ? 8u : 0u);
    } else {
      for (int round = 0; round < R; round++) {
        unsigned kh[4], kl[4];
#pragma unroll
        for (int qq = 0; qq < 4; qq++) {
          float bv = vq[qq][0]; int bi = 0;
          if (vq[qq][1] > bv) { bv = vq[qq][1]; bi = 1; }
          if (vq[qq][2] > bv) { bv = vq[qq][2]; bi = 2; }
          if (vq[qq][3] > bv) { bv = vq[qq][3]; bi = 3; }
          kh[qq] = bv >= 0.f ? (__float_as_uint(bv) | 0x80000000u) : 0u;
          kl[qq] = 255u - (unsigned)(sb + bi);
        }
#pragma unroll
        for (int off = 32; off > 0; off >>= 1) {
#pragma unroll
          for (int qq = 0; qq < 4; qq++) {
            const unsigned oh = __shfl_xor(kh[qq], off), ol = __shfl_xor(kl[qq], off);
            if (oh > kh[qq] || (oh == kh[qq] && ol > kl[qq])) { kh[qq] = oh; kl[qq] = ol; }
          }
        }
#pragma unroll
        for (int qq = 0; qq < 4; qq++) {
          const int sw = 255 - (int)kl[qq];
          if (kh[qq] != 0u && (sw >> 2) == lane) {
            const int i = sw & 3;
            if (i == 0) vq[qq][0] = -1.f; else if (i == 1) vq[qq][1] = -1.f; else if (i == 2) vq[qq][2] = -1.f; else vq[qq][3] = -1.f;
            nib[qq] |= 1u << i;
          }
        }
      }
    }
#pragma unroll
    for (int qq = 0; qq < 4; qq++) {
      unsigned w = nib[qq] << ((lane & 7) * 4);
      w |= __shfl_xor(w, 1); w |= __shfl_xor(w, 2); w |= __shfl_xor(w, 4);
      const int wi = lane >> 3;
      if (wi == 0) w |= 1u;
      if ((cur >> 5) == wi) w |= 1u << (cur & 31);
      if (cur >= 1 && ((cur - 1) >> 5) == wi) w |= 1u << ((cur - 1) & 31);
      if ((lane & 7) == 0) selw[qq * 8 + wi] = w;
    }
  }
  wave_lds_sync();
  f32x4 outv[4];
  {
    const float gc = NG[t * 32 + H] / fmaxf(sc.l, 1e-30f);
#pragma unroll
    for (int dt = 0; dt < 4; dt++) outv[dt] = sc.o[dt] * gc;
  }
  {
    AttnSt ss; attn_init(ss);
    const bf16_t* Kb = PR0 + C_KS + g * 64;
    const bf16_t* Vb = VST + (size_t)g * 64 * TP;
    for (int wd = 0; wd <= (cur >> 5); wd++) {
      const unsigned myw = selw[ql * 8 + wd];
      unsigned uw = __builtin_amdgcn_readfirstlane(selw[wd] | selw[8 + wd] | selw[16 + wd] | selw[24 + wd]);
      while (uw) {
        const int b = __builtin_ctz(uw);
        uw &= uw - 1u;
        const bool mine = (myw >> b) & 1u;
        attn_block_lds(Kb, LD0, Vb, TP, (wd * 32 + b) * 64, q0, q1, ss, [&](int key) { return mine && key <= t; }, stage, lane);
      }
    }
    attn_finish(ss);
    const float gs = NG[t * 32 + 8 + H] / fmaxf(ss.l, 1e-30f);
#pragma unroll
    for (int dt = 0; dt < 4; dt++) outv[dt] += ss.o[dt] * gs;
  }
  {
    AttnSt sw_; attn_init(sw_);
    const bf16_t* Kb = PR0 + C_KW + g * 64;
    const bf16_t* Vb = VWT + (size_t)g * 64 * TP;
    int start = t0 - 511; if (start < 0) start = 0;
    start &= ~63;
    for (int key0 = start; key0 <= t0 + 3; key0 += 64)
      attn_block_lds(Kb, LD0, Vb, TP, key0, q0, q1, sw_, [&](int key) { return key <= t && key > t - 512; }, stage, lane);
    attn_finish(sw_);
    const float gw = NG[t * 32 + 16 + H] / fmaxf(sw_.l, 1e-30f);
#pragma unroll
    for (int dt = 0; dt < 4; dt++) outv[dt] += sw_.o[dt] * gw;
  }
#pragma unroll
  for (int dt = 0; dt < 4; dt++) {
    const int d = dt * 16 + quad * 4;
    uint2 zv = *(const uint2*)(PR0 + (size_t)t * LD0 + C_NZ + H * 64 + d);
    const f32x4 a = outv[dt];
    uint2 r;
    r.x = pack2(a[0] * bflo(zv.x), a[1] * bfhi(zv.x));
    r.y = pack2(a[2] * bflo(zv.y), a[3] * bfhi(zv.y));
    *(uint2*)(CAT0 + (size_t)t * 1280 + H * 64 + d) = r;
  }
}

#define XB_TMO      128
#define XB_XCNT(j)  (256  + 64 * (j))
#define XB_XSUB(j)  (1280 + 64 * (j))
#define XB_XGEN(j)  (2304 + 64 * (j))
#define XB_TOP      3328
#define XB_TOPGEN   3392
#define XCD_BAR_WORDS 3456
#define XB_SPIN_CAP (1u << 18)
DI unsigned xb_ld(unsigned* p) { return __hip_atomic_load(p, __ATOMIC_RELAXED, __HIP_MEMORY_SCOPE_AGENT); }
DI unsigned xb_add(unsigned* p, unsigned v) { return __hip_atomic_fetch_add(p, v, __ATOMIC_RELAXED, __HIP_MEMORY_SCOPE_AGENT); }
DI unsigned xb_xcc_id() { return (unsigned)__builtin_amdgcn_s_getreg((3 << 11) | 20) & 0xFu; }
#define XB_SPIN(cond, bar) do { unsigned _sp = 0; while (cond) { __builtin_amdgcn_s_sleep(1); \
    if ((++_sp & 255u) == 0u) { if (xb_ld(&(bar)[XB_TMO])) break; if (_sp > XB_SPIN_CAP) { atomicAdd(&(bar)[XB_TMO], 1u); break; } } } } while (0)
struct XcdBarrier { unsigned* bar; unsigned x; unsigned nloc, nx; };
DI void xcd_barrier_complete(unsigned* bar, unsigned x, unsigned& nloc, unsigned& nx) {
  const unsigned G = gridDim.x * gridDim.y * gridDim.z;
  unsigned sum, cnt, mine, sp = 0u;
  for (;;) {
    sum = 0u; cnt = 0u; mine = 0u;
#pragma unroll
    for (unsigned j = 0; j < 16; ++j) { const unsigned c = xb_ld(&bar[XB_XCNT(j)]); sum += c; cnt += (c > 0u) ? 1u : 0u; mine = (j == x) ? c : mine; }
    if (sum == G) break;
    __builtin_amdgcn_s_sleep(1);
    if ((++sp & 255u) == 0u) { if (xb_ld(&bar[XB_TMO])) break; if (sp > XB_SPIN_CAP) { atomicAdd(&bar[XB_TMO], 1u); break; } }
  }
  nloc = mine > 0u ? mine : 1u; nx = cnt > 0u ? cnt : 1u;
}
DI void xcd_barrier(XcdBarrier& b) {
  asm volatile("s_waitcnt vmcnt(0)" ::: "memory");
  __syncthreads();
  if (threadIdx.x == 0) {
    unsigned* bar = b.bar;
    __builtin_amdgcn_s_waitcnt(0);
    if (b.nloc == 0u) xcd_barrier_complete(bar, b.x, b.nloc, b.nx);
    const unsigned nloc = b.nloc, nx = b.nx;
    const unsigned old = xb_add(&bar[XB_XSUB(b.x)], 1u);
    const unsigned gen = old / nloc;
    if (old + 1u == (gen + 1u) * nloc) {
      __builtin_amdgcn_fence(__ATOMIC_RELEASE, "agent");
      asm volatile("s_waitcnt vmcnt(0)" ::: "memory");
      const unsigned og = xb_add(&bar[XB_TOP], 1u);
      const unsigned tg = og / nx;
      if (og + 1u == (tg + 1u) * nx) xb_add(&bar[XB_TOPGEN], 1u);
      else XB_SPIN(xb_ld(&bar[XB_TOPGEN]) == tg, bar);
      __builtin_amdgcn_fence(__ATOMIC_ACQUIRE, "agent");
      xb_add(&bar[XB_XGEN(b.x)], 1u);
      asm volatile("s_waitcnt vmcnt(0)" ::: "memory");
    } else {
      XB_SPIN(xb_ld(&bar[XB_XGEN(b.x)]) == gen, bar);
      __builtin_amdgcn_fence(__ATOMIC_ACQUIRE, "agent");
      asm volatile("s_waitcnt vmcnt(0)" ::: "memory");
    }
  }
  __syncthreads();
}

#define PHASE_IDS                                                                                         \
  int tid_ = threadIdx.x;                                                                                 \
  asm volatile("" : "+v"(tid_));                                                                          \
  const int tid = tid_, lane = tid & 63, wave = tid >> 6, r16 = lane & 15, quad = lane >> 4, wm = wave >> 1, \
            wn = wave & 1, gw = bid * 4 + wave, gtid = bid * 256 + tid;                                   \
  (void)wm; (void)wn; (void)gw; (void)gtid; (void)r16; (void)quad; (void)lane; (void)tid;

DI void raster8(int sq, int TNN, int& tm_l, int& tn) {
  const int rg = sq / (8 * TNN), rem = sq % (8 * TNN);
  const int full = TNN >> 3;
  const int g = rem >> 6;
  if (g < full) { const int w = rem & 63; tm_l = rg * 8 + (w >> 3); tn = g * 8 + (w & 7); }
  else { const int r2 = rem - full * 64, w = TNN & 7; tm_l = rg * 8 + r2 / w; tn = full * 8 + r2 % w; }
}

__global__ void __launch_bounds__(256, 2) fwd_megakernel(Params p) {
  cg::grid_group grid = cg::this_grid();
  __shared__ __attribute__((aligned(16))) char smem_raw[81920];
  bf16_t* smem = (bf16_t*)smem_raw;
  const int tid = threadIdx.x, lane = tid & 63, wave = tid >> 6;
  const int r16 = lane & 15, quad = lane >> 4;
  const int wm = wave >> 1, wn = wave & 1;
  const int bid = blockIdx.x, nb = gridDim.x;
  const int gw = bid * 4 + wave, nw = nb * 4;
  const int gtid = bid * 256 + tid, nthr = nb * 256;
  char* ws = p.ws;
  bf16_t* Y0 = (bf16_t*)(ws + OFF_Y0);
  float* RSTD0 = (float*)(ws + OFF_RSTD0);
  float* RSTD1 = (float*)(ws + OFF_RSTD1);
  bf16_t* MEMN = (bf16_t*)(ws + OFF_MEMN);
  bf16_t* MEMK0 = (bf16_t*)(ws + OFF_MEMK0);
  bf16_t* MEMVT0 = (bf16_t*)(ws + OFF_MEMVT0);
  bf16_t* MEMK1 = (bf16_t*)(ws + OFF_MEMK1);
  bf16_t* MEMVT1 = (bf16_t*)(ws + OFF_MEMVT1);
  bf16_t* WMEM0T = (bf16_t*)(ws + OFF_WMEM0T);
  bf16_t* WMEM1T = (bf16_t*)(ws + OFF_WMEM1T);
  bf16_t* dO = (bf16_t*)p.out;
  unsigned long long* TS = (unsigned long long*)(ws + 33 * Mi + 262144);
  TSTAMP(0);
  XcdBarrier xb; xb.bar = (unsigned*)(ws + OFF_XBAR); xb.x = xb_xcc_id(); xb.nloc = 0u; xb.nx = 0u;
  if (threadIdx.x == 0) (void)xb_add(&xb.bar[XB_XCNT(xb.x)], 1u);

  {
    PHASE_IDS
    for (int t = gw; t < 256; t += nw) {
      const float4* xp = (const float4*)(p.mem + (size_t)t * 1024);
      float4 v[4]; float s = 0.f;
#pragma unroll
      for (int i = 0; i < 4; i++) { v[i] = xp[lane + i * 64]; s += v[i].x * v[i].x + v[i].y * v[i].y + v[i].z * v[i].z + v[i].w * v[i].w; }
#pragma unroll
      for (int o = 32; o > 0; o >>= 1) s += __shfl_xor(s, o);
      const float rs = rsqrtf(s * (1.f / 1024.f) + 1e-6f);
#pragma unroll
      for (int i = 0; i < 4; i++) {
        float4 gg = ((const float4*)p.mem_g)[lane + i * 64];
        uint2 r; r.x = pack2(v[i].x * rs * gg.x, v[i].y * rs * gg.y); r.y = pack2(v[i].z * rs * gg.z, v[i].w * rs * gg.w);
        *(uint2*)(MEMN + (size_t)t * 1024 + (lane + i * 64) * 4) = r;
      }
    }
    transpose_w(p.l0_wmem, 1024, 512, WMEM0T, 512, [](int n) { return n; }, (float*)smem_raw, bid, nb);
    transpose_w(p.l1_wmem, 1024, 512, WMEM1T, 512, [](int n) { return n; }, (float*)smem_raw, bid, nb);
#if DO_L0
    row_rstd(p.x, nullptr, RSTD0, (bf16_t*)(ws + OFF_XB0), T, gw, nw, lane);
    if (gtid < 512) ((int*)(ws + OFF_CNT))[gtid] = 0;
    transpose_w(p.l0_win, 1024, 4376, (bf16_t*)(ws + OFF_WT0), 4480,
                [](int n) { return n < 1280 ? n : (n < 4352 ? n + 24 : (n < 4376 ? n - 4352 + 1280 : -1)); },
                (float*)smem_raw, bid, nb, p.l0_g);
    transpose_w(p.l0_wout, 1280, 1024, (bf16_t*)(ws + OFF_WOUT0T), 1024, [](int n) { return n; }, (float*)smem_raw, bid, nb);
    transpose_w(p.w1_k, 2048, 64, (bf16_t*)(ws + OFF_W1KT), 64, [](int n) { return n; }, (float*)smem_raw, bid, nb);
    transpose_w(p.w1_v, 2048, 64, (bf16_t*)(ws + OFF_W1VT), 64, [](int n) { return n; }, (float*)smem_raw, bid, nb);
    transpose_w(p.w2_k, 64, 64, (bf16_t*)(ws + OFF_W2KT), 64, [](int n) { return n; }, (float*)smem_raw, bid, nb);
    transpose_w(p.w2_v, 64, 64, (bf16_t*)(ws + OFF_W2VT), 64, [](int n) { return n; }, (float*)smem_raw, bid, nb);
    {
      float* RC = (float*)(ws + OFF_ROPE0C); float* RS = (float*)(ws + OFF_ROPE0S);
      for (int i = gtid; i < T * 32; i += nthr) {
        const int t = i >> 5, d = i & 31;
        const double inv = exp2(-(double)d / 32.0 * 13.287712379549449);
        const double rev = (double)p.pos[t] * inv * 0.15915494309189535;
        const float fr = (float)(rev - floor(rev));
        RC[i] = __builtin_amdgcn_cosf(fr); RS[i] = __builtin_amdgcn_sinf(fr);
      }
    }
#endif
  }
  if (gridDim.x == 0x7fffffffu) grid.sync();
  xcd_barrier(xb);
  TSTAMP(1);

#if DO_L0
  {
    PHASE_IDS
    const bf16_t* WT0 = (const bf16_t*)(ws + OFF_WT0);
    bf16_t* PR0 = (bf16_t*)(ws + OFF_PR0);
    const float* RC = (const float*)(ws + OFF_ROPE0C); const float* RS = (const float*)(ws + OFF_ROPE0S);
    float* NG = (float*)(ws + OFF_NG);
    const bf16_t* XB0 = (const bf16_t*)(ws + OFF_XB0);
    for (int it = bid; it < 16; it += nb) {
        const int j = it, layer = j >> 3, tm = (j >> 2) & 1, tn = j & 3;
        const bf16_t* Wt = layer ? WMEM1T : WMEM0T;
        bf16_t* MK = layer ? MEMK1 : MEMK0; bf16_t* MV = layer ? MEMVT1 : MEMVT0;
        const int m0 = tm * 128, n0 = tn * 128;
        auto la = [&](int kt, int row, int ch) { return ld_bf(MEMN, 1024, m0 + row, kt, ch); };
        auto lb = [&](int kt, int row, int ch) { return ld_bf(Wt, 1024, n0 + row, kt, ch); };
        f32x4 acc[4][4]; zero_acc(acc);
        if (n0 < 256) {
          gemm_tile<4, 4, true>(acc, 16, la, lb, smem);
#pragma unroll
          for (int i = 0; i < 4; i++)
#pragma unroll
            for (int jj = 0; jj < 4; jj++) {
              const int m = m0 + wm * 64 + i * 16 + r16, n = n0 + wn * 64 + jj * 16 + quad * 4;
              *(uint2*)(MK + (size_t)m * 256 + n) = pack4(acc[i][jj]);
            }
        } else {
          gemm_tile<4, 4, false>(acc, 16, la, lb, smem);
#pragma unroll
          for (int i = 0; i < 4; i++)
#pragma unroll
            for (int jj = 0; jj < 4; jj++) {
              const int m = m0 + wm * 64 + i * 16 + quad * 4, n = n0 + wn * 64 + jj * 16 + r16 - 256;
              *(uint2*)(MV + (size_t)n * 256 + m) = pack4(acc[i][jj]);
            }
        }
    }
    const int xcd = bid & 7, lid = bid >> 3, nl = nb >> 3;
    for (int sq = lid; sq < 16 * 35; sq += nl) {
      int tml, tn; raster8(sq, 35, tml, tn);
      const int tm = xcd * 16 + tml;
      const int m0 = tm * 128, n0 = tn * 128;
      auto la = [&](int kt, int row, int ch) { return ld_bf(XB0, 1024, m0 + row, kt, ch); };
      auto lb = [&](int kt, int row, int ch) { return ld_bf(WT0, 1024, n0 + row, kt, ch); };
      f32x4 acc[4][4]; zero_acc(acc);
      const bool isT = (n0 == C_VS) || (n0 == C_VW) || (n0 >= C_MV && n0 < C_MZ);
      if (isT) {
        gemm_tile<4, 4, false>(acc, 16, la, lb, smem);
        bf16_t* dst; int nbase;
        if (n0 == C_VS) { dst = (bf16_t*)(ws + OFF_VST); nbase = C_VS; }
        else if (n0 == C_VW) { dst = (bf16_t*)(ws + OFF_VWT); nbase = C_VW; }
        else { dst = (bf16_t*)(ws + OFF_MVT); nbase = C_MV; }
#pragma unroll
        for (int i = 0; i < 4; i++)
#pragma unroll
          for (int jj = 0; jj < 4; jj++) {
            const int m = m0 + wm * 64 + i * 16 + quad * 4, n = n0 + wn * 64 + jj * 16 + r16 - nbase;
            const f32x4 rs4 = *(const f32x4*)(RSTD0 + m);
            *(uint2*)(dst + (size_t)n * TP + m) = pack4(acc[i][jj] * rs4);
          }
      } else {
        gemm_tile<4, 4, true>(acc, 16, la, lb, smem);
        const int nbw = n0 + wn * 64;
        const bool rope = (nbw < 640) || (nbw >= C_KS && nbw < C_VS) || (nbw >= C_KW && nbw < C_VW) || (nbw >= C_MQ && nbw < C_MV);
        const bool qs = (nbw < 512) || (nbw >= C_MQ && nbw < C_MK) || (nbw >= C_EQ && nbw < C_EZ);
        const bool sl = (nbw >= C_NZ && nbw < C_MQ) || (nbw >= C_MZ && nbw < C_EQ) || (nbw >= C_EZ && nbw < C_NG);
#pragma unroll
        for (int i = 0; i < 4; i++) {
          const int t = m0 + wm * 64 + i * 16 + r16;
          {
            const float rs = RSTD0[t];
#pragma unroll
            for (int jj = 0; jj < 4; jj++) acc[i][jj] *= rs;
          }
          if (n0 == C_NG) {
            if (wn == 0) {
#pragma unroll
              for (int jj = 0; jj < 2; jj++)
#pragma unroll
                for (int r = 0; r < 4; r++) {
                  const int idx = jj * 16 + quad * 4 + r;
                  if (idx < 24) NG[t * 32 + idx] = sigm_f(acc[i][jj][r] + p.l0_gb[idx]);
                }
            }
            continue;
          }
          if (rope) {
#pragma unroll
            for (int jj = 0; jj < 2; jj++) {
              const int d0 = jj * 16 + quad * 4;
              const f32x4 cc = *(const f32x4*)(RC + t * 32 + d0);
              const f32x4 ssn = *(const f32x4*)(RS + t * 32 + d0);
              f32x4 x1 = acc[i][jj], x2 = acc[i][jj + 2];
#pragma unroll
              for (int r = 0; r < 4; r++) {
                acc[i][jj][r] = x1[r] * cc[r] - x2[r] * ssn[r];
                acc[i][jj + 2][r] = x1[r] * ssn[r] + x2[r] * cc[r];
              }
            }
          }
#pragma unroll
          for (int jj = 0; jj < 4; jj++) {
            f32x4 v = acc[i][jj];
            if (qs) { v[0] *= QSCALE; v[1] *= QSCALE; v[2] *= QSCALE; v[3] *= QSCALE; }
            if (sl) { v[0] = silu_f(v[0]); v[1] = silu_f(v[1]); v[2] = silu_f(v[2]); v[3] = silu_f(v[3]); }
            *(uint2*)(PR0 + (size_t)t * LD0 + nbw + jj * 16 + quad * 4) = pack4(v);
          }
        }
      }
    }
  }
  xcd_barrier(xb);
  TSTAMP(2);

  {
    PHASE_IDS
    const bf16_t* PR0 = (const bf16_t*)(ws + OFF_PR0);
    bf16_t* KMEAN = (bf16_t*)(ws + OFF_KMEAN);
    bf16_t* HID = (bf16_t*)(ws + OFF_HID);
    for (int it = bid; it < 64 + 512; it += nb) {
      if (it >= 64) {
        const int j = it - 64, n = j >> 3, hd_ = (j & 7) * 64 + (tid & 63), part = tid >> 6;
        float s = 0.f;
#pragma unroll 8
        for (int r = 0; r < 64; r++) s += bf2f(PR0[(size_t)(n * 256 + part * 64 + r) * LD0 + C_MK + hd_]);
        float* red = (float*)smem_raw;
        red[tid] = s;
        __syncthreads();
        if (part == 0) KMEAN[n * 512 + hd_] = f2bf((red[tid] + red[tid + 64] + red[tid + 128] + red[tid + 192]) * (1.f / 256.f));
        __syncthreads();
        continue;
      }
      const int var = it >> 4, mt = it & 15;
      const int isv = var >> 1, g = var & 1;
      const int m0 = mt * 64;
      const int coff = (isv ? C_VCI : C_KCI) + g * 64;
      const bf16_t* W1T = (const bf16_t*)(ws + (isv ? OFF_W1VT : OFF_W1KT));
      const bf16_t* W2T = (const bf16_t*)(ws + (isv ? OFF_W2VT : OFF_W2KT));
      const float* pe = isv ? p.pe_v : p.pe_k;
      auto la = [&](int kt, int row, int ch) -> uint4 {
        const int n = m0 + row;
        if (n > 1022) return make_uint4(0, 0, 0, 0);
        const uint4 av = *(const uint4*)(PR0 + (size_t)(16 * n + kt) * LD0 + coff + ch * 8);
        const float4 p0 = *(const float4*)(pe + kt * 64 + ch * 8), p1 = *(const float4*)(pe + kt * 64 + ch * 8 + 4);
        uint4 r;
        r.x = pack2(bflo(av.x) + p0.x, bfhi(av.x) + p0.y); r.y = pack2(bflo(av.y) + p0.z, bfhi(av.y) + p0.w);
        r.z = pack2(bflo(av.z) + p1.x, bfhi(av.z) + p1.y); r.w = pack2(bflo(av.w) + p1.z, bfhi(av.w) + p1.w);
        return r;
      };
      auto lb = [&](int kt, int row, int ch) { return ld_bf(W1T, 2048, row, kt, ch); };
      f32x4 acc[2][2]; zero_acc(acc);
      gemm_tile<2, 2, true>(acc, 32, la, lb, smem);
      bf16_t* hid = HID + (size_t)var * 1024 * 64;
#pragma unroll
      for (int i = 0; i < 2; i++)
#pragma unroll
        for (int jj = 0; jj < 2; jj++) {
          const int m = m0 + wm * 32 + i * 16 + r16, n = wn * 32 + jj * 16 + quad * 4;
          f32x4 v = acc[i][jj];
#pragma unroll
          for (int r = 0; r < 4; r++) v[r] = silu_f(v[r]);
          *(uint2*)(hid + (size_t)m * 64 + n) = pack4(v);
        }
      __threadfence_block();
      __syncthreads();
      auto la2 = [&](int kt, int row, int ch) { return ld_bf(hid, 64, m0 + row, kt, ch); };
      auto lb2 = [&](int kt, int row, int ch) { return ld_bf(W2T, 64, row, kt, ch); };
      f32x4 acc2[2][2]; zero_acc(acc2);
      if (!isv) {
        gemm_tile<2, 2, true>(acc2, 1, la2, lb2, smem);
        bf16_t* KC = (bf16_t*)(ws + OFF_KC);
#pragma unroll
        for (int i = 0; i < 2; i++)
#pragma unroll
          for (int jj = 0; jj < 2; jj++) {
            const int m = m0 + wm * 32 + i * 16 + r16, n = wn * 32 + jj * 16 + quad * 4;
            *(uint2*)(KC + (size_t)m * 128 + g * 64 + n) = pack4(acc2[i][jj]);
          }
      } else {
        gemm_tile<2, 2, false>(acc2, 1, la2, lb2, smem);
        bf16_t* VCT = (bf16_t*)(ws + OFF_VCT);
#pragma unroll
        for (int i = 0; i < 2; i++)
#pragma unroll
          for (int jj = 0; jj < 2; jj++) {
            const int m = m0 + wm * 32 + i * 16 + quad * 4, n = wn * 32 + jj * 16 + r16;
            *(uint2*)(VCT + (size_t)(g * 64 + n) * 1024 + m) = pack4(acc2[i][jj]);
          }
      }
    }
  }
  xcd_barrier(xb);
  TSTAMP(3);

  {
    PHASE_IDS
    const bf16_t* PR0 = (const bf16_t*)(ws + OFF_PR0);
    float* impw = (float*)(smem_raw + wave * 18432);
    unsigned* selw = (unsigned*)(smem_raw + 73728) + wave * 32;
    const int N_NSA = 4096 * 2, N_MOBA = 1024 * 8, N_MEM = 1024 * 4;
    for (int it = gw; it < N_NSA + N_MOBA + N_MEM; it += nw) {
      if (it < N_NSA) {
        const int qt = it >> 1, g = it & 1;
        nsa_item(PR0, (const bf16_t*)(ws + OFF_KC), (const bf16_t*)(ws + OFF_VCT), (const bf16_t*)(ws + OFF_VST),
                 (const bf16_t*)(ws + OFF_VWT), (const float*)(ws + OFF_NG), dO, qt * 4, g, impw, selw, lane);
      } else if (it < N_NSA + N_MOBA) {
        const int j = it - N_NSA;
        moba_item(PR0, (const bf16_t*)(ws + OFF_MVT), (const bf16_t*)(ws + OFF_KMEAN), dO, (int*)(ws + OFF_CNT),
                  (int*)((char*)p.out + DOFF_BUCKET), (float*)(ws + OFF_LSESEL), (float*)(ws + OFF_LSEOWN), (j >> 3) * 16, j & 7, lane, (char*)impw);
      } else {
        const int j = it - N_NSA - N_MOBA;
        mem_attn_item(PR0 + C_EQ, LD0, PR0 + C_EZ, LD0, dO + 1024, 1280, MEMK0, MEMVT0, (j >> 2) * 16, j & 3, lane, (char*)impw);
      }
    }
  }
  xcd_barrier(xb);
  TSTAMP(4);

  {
    PHASE_IDS
    const bf16_t* PR0 = (const bf16_t*)(ws + OFF_PR0);
    const int* CNT = (const int*)(ws + OFF_CNT);
    unsigned tcl = 0, tch = 0;
    int lsum = 0;
#pragma unroll
    for (int i = 0; i < 8; i++) {
      const int c = (CNT[lane * 8 + i] + 63) >> 6;
      lsum += c;
      if (i < 4) tcl |= (unsigned)c << (8 * i); else tch |= (unsigned)c << (8 * (i - 4));
    }
    int incl = lsum;
#pragma unroll
    for (int o = 1; o < 64; o <<= 1) { int v = __shfl_up(incl, o); if (lane >= o) incl += v; }
    const int excl = incl - lsum;
    const int total = __shfl(incl, 63);
    for (int it = gw; it < total; it += nw) {
      const unsigned long long bal = __ballot(excl <= it);
      const int owner = 63 - __builtin_clzll(bal);
      int rem = it - excl, pi = 0, tj = 0;
#pragma unroll
      for (int i = 0; i < 8; i++) {
        const int c = (int)(((i < 4 ? tcl : tch) >> (8 * (i & 3))) & 0xffu);
        if (rem >= 0 && rem < c) { pi = i; tj = rem; rem = -1; }
        else if (rem >= 0) rem -= c;
      }
      const int pair = owner * 8 + __shfl(pi, owner);
      const int tile = __shfl(tj, owner);
      const int count = CNT[pair];
      moba_bucket_item(PR0, (const bf16_t*)(ws + OFF_MVT), (const int*)((char*)p.out + DOFF_BUCKET), ws,
                       (float*)(ws + OFF_LSESEL), pair >> 6, pair & 63, tile * 64, count, lane);
    }
  }
  xcd_barrier(xb);
  {
    PHASE_IDS
    const bf16_t* PR0 = (const bf16_t*)(ws + OFF_PR0);
    const float* LSESEL = (const float*)(ws + OFF_LSESEL);
    const float* LSEOWN = (const float*)(ws + OFF_LSEOWN);
    for (int i = gtid; i < T * 64; i += nthr) {
      const int c8 = i & 7, h = (i >> 3) & 7, t = i >> 6;
      const float lo = LSEOWN[(size_t)t * 8 + h];
      const float l0 = LSESEL[((size_t)t * 8 + h) * 3 + 0], l1 = LSESEL[((size_t)t * 8 + h) * 3 + 1], l2 = LSESEL[((size_t)t * 8 + h) * 3 + 2];
      const float M = fmaxf(fmaxf(lo, l0), fmaxf(l1, l2));
      float wo = ex2(lo - M), w0 = ex2(l0 - M), w1 = ex2(l1 - M), w2 = ex2(l2 - M);
      const float inv = 1.f / (wo + w0 + w1 + w2);
      wo *= inv; w0 *= inv; w1 *= inv; w2 *= inv;
      const bf16_t* part = (const bf16_t*)(ws + (h < 5 ? OFF_PARTA + (size_t)h * PART_HEAD : OFF_PARTB + (size_t)(h - 5) * PART_HEAD)) + (size_t)t * 192 + c8 * 8;
      bf16_t* dst = dO + (size_t)t * 1280 + 512 + h * 64 + c8 * 8;
      const uint4 ov = *(const uint4*)dst;
      const uint4 zv = *(const uint4*)(PR0 + (size_t)t * LD0 + C_MZ + h * 64 + c8 * 8);
      uint4 a0 = make_uint4(0, 0, 0, 0), a1 = a0, a2 = a0;
      if (w0 > 0.f) a0 = *(const uint4*)(part);
      if (w1 > 0.f) a1 = *(const uint4*)(part + 64);
      if (w2 > 0.f) a2 = *(const uint4*)(part + 128);
      const unsigned ou[4] = {ov.x, ov.y, ov.z, ov.w}, zu[4] = {zv.x, zv.y, zv.z, zv.w};
      const unsigned u0[4] = {a0.x, a0.y, a0.z, a0.w}, u1[4] = {a1.x, a1.y, a1.z, a1.w}, u2[4] = {a2.x, a2.y, a2.z, a2.w};
      unsigned ru[4];
#pragma unroll
      for (int j = 0; j < 4; j++) {
        const float lo_ = (wo * bflo(ou[j]) + w0 * bflo(u0[j]) + w1 * bflo(u1[j]) + w2 * bflo(u2[j])) * bflo(zu[j]);
        const float hi_ = (wo * bfhi(ou[j]) + w0 * bfhi(u0[j]) + w1 * bfhi(u1[j]) + w2 * bfhi(u2[j])) * bfhi(zu[j]);
        ru[j] = pack2(lo_, hi_);
      }
      *(uint4*)dst = make_uint4(ru[0], ru[1], ru[2], ru[3]);
    }
  }
  xcd_barrier(xb);
  {
    PHASE_IDS
    const bf16_t* WO = (const bf16_t*)(ws + OFF_WOUT0T);
    const int xcd = bid & 7, lid = bid >> 3, nl = nb >> 3;
    for (int sq = lid; sq < 16 * 8; sq += nl) {
      int tml, tn; raster8(sq, 8, tml, tn);
      const int tm = xcd * 16 + tml;
      const int m0 = tm * 128, n0 = tn * 128;
      auto la = [&](int kt, int row, int ch) { return ld_bf(dO, 1280, m0 + row, kt, ch); };
      auto lb = [&](int kt, int row, int ch) { return ld_bf(WO, 1280, n0 + row, kt, ch); };
      f32x4 acc[4][4]; zero_acc(acc);
      gemm_tile<4, 4, true, true>(acc, 20, la, lb, smem);
#pragma unroll
      for (int i = 0; i < 4; i++) {
        const int m = m0 + wm * 64 + i * 16 + r16, nb16 = n0 + wn * 64 + quad * 16;
        uint2 pk[4];
#pragma unroll
        for (int jj = 0; jj < 4; jj++) {
          const f32x4 xv = *(const f32x4*)(p.x + (size_t)m * 1024 + nb16 + jj * 4);
          pk[jj] = pack4(acc[i][jj] + xv);
        }
        *(uint4*)(Y0 + (size_t)m * 1024 + nb16) = make_uint4(pk[0].x, pk[0].y, pk[1].x, pk[1].y);
        *(uint4*)(Y0 + (size_t)m * 1024 + nb16 + 8) = make_uint4(pk[2].x, pk[2].y, pk[3].x, pk[3].y);
      }
    }
  }
  xcd_barrier(xb);
  TSTAMP(5);
#else
  {
    for (int i = gtid; i < T * 1024 / 4; i += nthr) { const float4 v = ((const float4*)p.x)[i]; uint2 o; o.x = pack2(v.x, v.y); o.y = pack2(v.z, v.w); ((uint2*)Y0)[i] = o; }
    for (int it = bid; it < 8; it += nb) {
      const int tm = (it >> 2) & 1, tn = it & 3;
      const int m0 = tm * 128, n0 = tn * 128;
      auto la = [&](int kt, int row, int ch) { return ld_bf(MEMN, 1024, m0 + row, kt, ch); };
      auto lb = [&](int kt, int row, int ch) { return ld_bf(WMEM1T, 1024, n0 + row, kt, ch); };
      f32x4 acc[4][4]; zero_acc(acc);
      if (n0 < 256) {
        gemm_tile<4, 4, true>(acc, 16, la, lb, smem);
#pragma unroll
        for (int i = 0; i < 4; i++)
#pragma unroll
          for (int jj = 0; jj < 4; jj++) {
            const int m = m0 + wm * 64 + i * 16 + r16, n = n0 + wn * 64 + jj * 16 + quad * 4;
            *(uint2*)(MEMK1 + (size_t)m * 256 + n) = pack4(acc[i][jj]);
          }
      } else {
        gemm_tile<4, 4, false>(acc, 16, la, lb, smem);
#pragma unroll
        for (int i = 0; i < 4; i++)
#pragma unroll
          for (int jj = 0; jj < 4; jj++) {
            const int m = m0 + wm * 64 + i * 16 + quad * 4, n = n0 + wn * 64 + jj * 16 + r16 - 256;
            *(uint2*)(MEMVT1 + (size_t)n * 256 + m) = pack4(acc[i][jj]);
          }
      }
    }
  }
  xcd_barrier(xb);
  TSTAMP(5);
#endif

  {
    PHASE_IDS
    for (int t = gw; t < T; t += nw) {
      const uint4 a = *(const uint4*)(Y0 + (size_t)t * 1024 + lane * 8), b = *(const uint4*)(Y0 + (size_t)t * 1024 + 512 + lane * 8);
      const unsigned u[8] = {a.x, a.y, a.z, a.w, b.x, b.y, b.z, b.w};
      float sq = 0.f;
#pragma unroll
      for (int i = 0; i < 8; i++) { const float lo = bflo(u[i]), hi = bfhi(u[i]); sq += lo * lo + hi * hi; }
#pragma unroll
      for (int o = 32; o > 0; o >>= 1) sq += __shfl_xor(sq, o);
      if (lane == 0) RSTD1[t] = rsqrtf(sq * (1.f / 1024.f) + 1e-6f);
    }
    auto perm = [](int x) { const int h = x >> 8, r = x & 255; return h * 256 + ((r >> 5) & 1) * 128 + (r >> 6) * 32 + (r & 31); };
    transpose_w(p.l1_win, 1024, 6656, (bf16_t*)(ws + OFF_WT1), 4608,
                [&](int n) { return n < 1024 ? perm(n) : (n < 2048 ? 1024 + perm(n - 1024) : (n < 4096 ? n : n + 2048)); },
                (float*)smem_raw, bid, nb, p.l1_g);
    transpose_w(p.l1_win, 1024, 6656, (bf16_t*)(ws + OFF_WRZT), 2048, [](int n) { return 4096 + n; }, (float*)smem_raw, bid, nb, p.l1_g);
    transpose_w(p.l1_wout, 2304, 1024, (bf16_t*)(ws + OFF_WOUT1T), 1024, [](int n) { return n; }, (float*)smem_raw, bid, nb);
    float* RC = (float*)(ws + OFF_ROPE1C); float* RS = (float*)(ws + OFF_ROPE1S);
    for (int i = gtid; i < T * 128; i += nthr) {
      const int t = i >> 7, d = i & 127;
      const double inv = exp2(-(double)d / 127.0 * 13.287712379549449);
      const double rev = (double)p.pos[t] * inv * 0.15915494309189535;
      const float fr = (float)(rev - floor(rev));
      RC[i] = __builtin_amdgcn_cosf(fr); RS[i] = __builtin_amdgcn_sinf(fr);
    }
  }
  xcd_barrier(xb);
  TSTAMP(6);

  bf16_t* Q1 = dO;
  bf16_t* P1 = (bf16_t*)((char*)p.out + DOFF_P);
  bf16_t* KP = (bf16_t*)(ws + OFF_KP);
  bf16_t* KPT = (bf16_t*)(ws + OFF_KPT);
  bf16_t* VT = (bf16_t*)(ws + OFF_VT);
  bf16_t* S1 = (bf16_t*)(ws + OFF_S);
  bf16_t* EQ1 = (bf16_t*)(ws + OFF_EQ1);
  bf16_t* EZ1 = (bf16_t*)(ws + OFF_EZ1);
  bf16_t* O1 = (bf16_t*)(ws + OFF_O);
  bf16_t* Z1 = (bf16_t*)(ws + OFF_Z);

  {
    PHASE_IDS
    const bf16_t* WT1 = (const bf16_t*)(ws + OFF_WT1);
    const float* RC = (const float*)(ws + OFF_ROPE1C); const float* RS = (const float*)(ws + OFF_ROPE1S);
    const bf16_t* XB1 = Y0;
    const int xcd = bid & 7, lid = bid >> 3, nl = nb >> 3;
    for (int sq = lid; sq < 16 * 36; sq += nl) {
      int tml, tn; raster8(sq, 36, tml, tn);
      const int tm = xcd * 16 + tml;
      const int m0 = tm * 128, n0 = tn * 128;
      auto la = [&](int kt, int row, int ch) { return ld_bf(XB1, 1024, m0 + row, kt, ch); };
      auto lb = [&](int kt, int row, int ch) { return ld_bf(WT1, 1024, n0 + row, kt, ch); };
      f32x4 acc[4][4]; zero_acc(acc);
      if (n0 >= 2048 && n0 < 4096) {
        gemm_tile<4, 4, false>(acc, 16, la, lb, smem);
#pragma unroll
        for (int i = 0; i < 4; i++)
#pragma unroll
          for (int jj = 0; jj < 4; jj++) {
            const int m = m0 + wm * 64 + i * 16 + quad * 4, n = n0 + wn * 64 + jj * 16 + r16 - 2048;
            const f32x4 rs4 = *(const f32x4*)(RSTD1 + m);
            *(uint2*)(VT + (size_t)n * TP + m) = pack4(acc[i][jj] * rs4);
          }
      } else {
        gemm_tile<4, 4, true>(acc, 16, la, lb, smem);
        const int nbw = n0 + wn * 64;
#pragma unroll
        for (int i = 0; i < 4; i++) {
          const int t = m0 + wm * 64 + i * 16 + r16;
          {
            const float rs = RSTD1[t];
#pragma unroll
            for (int jj = 0; jj < 4; jj++) acc[i][jj] *= rs;
          }
          if (nbw < 2048) {
            const int cgrp = (nbw & 255) >> 6;
#pragma unroll
            for (int jj = 0; jj < 2; jj++) {
              const int d0 = cgrp * 32 + jj * 16 + quad * 4;
              const f32x4 cc = *(const f32x4*)(RC + t * 128 + d0);
              const f32x4 ssn = *(const f32x4*)(RS + t * 128 + d0);
              f32x4 x1 = acc[i][jj], x2 = acc[i][jj + 2];
#pragma unroll
              for (int r = 0; r < 4; r++) {
                acc[i][jj][r] = x1[r] * cc[r] - x2[r] * ssn[r];
                acc[i][jj + 2][r] = x1[r] * ssn[r] + x2[r] * cc[r];
              }
            }
            if (nbw < 1024) {
#pragma unroll
              for (int jj = 0; jj < 4; jj++)
                *(uint2*)(Q1 + (size_t)t * 1024 + nbw + jj * 16 + quad * 4) = pack4(acc[i][jj]);
            } else {
              const int h = (nbw - 1024) >> 8;
              const float lg = log2f(1.f - exp2f(-5.f - (float)h));
              const float ksc = 0.0625f * exp2f(-(float)((t & 255) + 1) * lg);
#pragma unroll
              for (int jj = 0; jj < 4; jj++) {
                f32x4 v = acc[i][jj];
                v[0] *= ksc; v[1] *= ksc; v[2] *= ksc; v[3] *= ksc;
                const int n = nbw - 1024 + jj * 16 + quad * 4;
                *(uint2*)(KP + (size_t)t * 1024 + n) = pack4(v);
#pragma unroll
                for (int r = 0; r < 4; r++) KPT[(size_t)(n + r) * TP + t] = f2bf(v[r]);
              }
            }
          } else if (nbw < 4352) {
#pragma unroll
            for (int jj = 0; jj < 4; jj++) {
              f32x4 v = acc[i][jj];
              v[0] *= QSCALE; v[1] *= QSCALE; v[2] *= QSCALE; v[3] *= QSCALE;
              *(uint2*)(EQ1 + (size_t)t * 256 + nbw - 4096 + jj * 16 + quad * 4) = pack4(v);
            }
          } else {
#pragma unroll
            for (int jj = 0; jj < 4; jj++) {
              f32x4 v = acc[i][jj];
              v[0] = silu_f(v[0]); v[1] = silu_f(v[1]); v[2] = silu_f(v[2]); v[3] = silu_f(v[3]);
              *(uint2*)(EZ1 + (size_t)t * 256 + nbw - 4352 + jj * 16 + quad * 4) = pack4(v);
            }
          }
        }
      }
    }
  }
  xcd_barrier(xb);
  TSTAMP(7);

  {
    PHASE_IDS
    const int xcd7 = bid & 7, lid7 = bid >> 3, nl7 = nb >> 3;
    for (int sq = lid7; sq < 512; sq += nl7) {
      const int it = xcd7 * 512 + sq;
      if (it < 2048) {
        const int h = it >> 9, c = (it >> 3) & 63, tm = (it >> 1) & 3, tn = it & 1;
        const bf16_t* Ab = VT + (size_t)(h * 512 + tm * 128) * TP + c * 256;
        const bf16_t* Bb = KPT + (size_t)(h * 256 + tn * 128) * TP + c * 256;
        auto la = [&](int kt, int row, int ch) { return ld_bf(Ab, TP, row, kt, ch); };
        auto lb = [&](int kt, int row, int ch) { return ld_bf(Bb, TP, row, kt, ch); };
        f32x4 acc[4][4]; zero_acc(acc);
        gemm_tile<4, 4, true>(acc, 4, la, lb, smem);
        bf16_t* Sd = S1 + ((size_t)(h * 64 + c) * 512 + tm * 128) * 256 + tn * 128;
#pragma unroll
        for (int i = 0; i < 4; i++)
#pragma unroll
          for (int jj = 0; jj < 4; jj++) {
            const int m = wm * 64 + i * 16 + r16, n = wn * 64 + jj * 16 + quad * 4;
            *(uint2*)(Sd + (size_t)m * 256 + n) = pack4(acc[i][jj]);
          }
      } else if (it < 3072) {
        const int j = it - 2048;
        const int h = j >> 8, c = (j >> 2) & 63, tm = (j >> 1) & 1, tn = j & 1;
        const int m0 = c * 256 + tm * 128, n0 = c * 256 + tn * 128;
        auto la = [&](int kt, int row, int ch) { return ld_bf(Q1 + h * 256, 1024, m0 + row, kt, ch); };
        auto lb = [&](int kt, int row, int ch) { return ld_bf(KP + h * 256, 1024, n0 + row, kt, ch); };
        f32x4 acc[4][4]; zero_acc(acc);
        if (tn <= tm) gemm_tile<4, 4, true>(acc, 4, la, lb, smem);
#pragma unroll
        for (int i = 0; i < 4; i++)
#pragma unroll
          for (int jj = 0; jj < 4; jj++) {
            const int m = m0 + wm * 64 + i * 16 + r16, n = n0 + wn * 64 + jj * 16 + quad * 4;
            f32x4 v = acc[i][jj];
#pragma unroll
            for (int r = 0; r < 4; r++) if (n + r > m) v[r] = 0.f;
            *(uint2*)(P1 + ((size_t)h * T + m) * 256 + (n - c * 256)) = pack4(v);
          }
      } else {
        const int j = (it - 3072) * 4 + wave;
        mem_attn_item(EQ1, 256, EZ1, 256, EQ1, 256, MEMK1, MEMVT1, (j >> 2) * 16, j & 3, lane, smem_raw + wave * 18432);
      }
    }
  }
  xcd_barrier(xb);
  {
    PHASE_IDS
    for (int e = gtid; e < 4 * 16384; e += nthr) {
      const int h = e >> 14, idx = (e & 16383) * 8;
      const float gL = exp2f(256.f * log2f(1.f - exp2f(-5.f - (float)h)));
      float s0 = 0.f, s1 = 0.f, s2 = 0.f, s3 = 0.f, s4 = 0.f, s5 = 0.f, s6 = 0.f, s7 = 0.f;
      bf16_t* base = S1 + (((size_t)h * 64) << 17) + idx;
      uint4 u = *(const uint4*)base;
      for (int c = 0; c < 64; c++) {
        uint4* pp = (uint4*)(base + ((size_t)c << 17));
        uint4 un = u;
        if (c + 1 < 64) un = *(const uint4*)(base + ((size_t)(c + 1) << 17));
        uint4 o;
        o.x = pack2(s0, s1); o.y = pack2(s2, s3); o.z = pack2(s4, s5); o.w = pack2(s6, s7);
        *pp = o;
        s0 = gL * (s0 + bflo(u.x)); s1 = gL * (s1 + bfhi(u.x));
        s2 = gL * (s2 + bflo(u.y)); s3 = gL * (s3 + bfhi(u.y));
        s4 = gL * (s4 + bflo(u.z)); s5 = gL * (s5 + bfhi(u.z));
        s6 = gL * (s6 + bflo(u.w)); s7 = gL * (s7 + bfhi(u.w));
        u = un;
      }
    }
  }
  xcd_barrier(xb);
  TSTAMP(8);

  {
    PHASE_IDS
    const int xcd8 = bid & 7, lid8 = bid >> 3, nl8 = nb >> 3;
    for (int sq = lid8; sq < 256; sq += nl8) {
      const int it = xcd8 * 256 + sq;
      const int h = it >> 9, c = (it >> 3) & 63, tm = (it >> 2) & 1, tn = it & 3;
      const int m0 = c * 256 + tm * 128, n0 = tn * 128;
      const bf16_t* Sb = S1 + ((size_t)(h * 64 + c) * 512 + n0) * 256;
      const bf16_t* Pb = P1 + ((size_t)h * T + m0) * 256;
      const bf16_t* Vb = VT + (size_t)(h * 512 + n0) * TP + c * 256;
      const bf16_t* Qb = Q1 + (size_t)m0 * 1024 + h * 256;
      auto la = [&](int kt, int row, int ch) {
        const bf16_t* b = kt < 4 ? Qb : Pb; const int ld = kt < 4 ? 1024 : 256;
        return *(const uint4*)(b + (size_t)(row * ld) + (kt & 3) * 64 + ch * 8);
      };
      auto lb = [&](int kt, int row, int ch) {
        const bf16_t* b = kt < 4 ? Sb : Vb; const int ld = kt < 4 ? 256 : TP;
        return *(const uint4*)(b + (size_t)(row * ld) + (kt & 3) * 64 + ch * 8);
      };
      f32x4 acc[4][4]; zero_acc(acc);
      gemm_tile<4, 4, true>(acc, tm == 0 ? 6 : 8, la, lb, smem);
      const float lg = log2f(1.f - exp2f(-5.f - (float)h));
#pragma unroll
      for (int i = 0; i < 4; i++) {
        const int t = m0 + wm * 64 + i * 16 + r16;
        const float qd = exp2f((float)((t & 255) + 1) * lg);
#pragma unroll
        for (int jj = 0; jj < 4; jj++) {
          f32x4 v = acc[i][jj];
          v[0] *= qd; v[1] *= qd; v[2] *= qd; v[3] *= qd;
          *(uint2*)(O1 + (size_t)t * 2048 + h * 512 + n0 + wn * 64 + jj * 16 + quad * 4) = pack4(v);
        }
      }
    }
  }
  xcd_barrier(xb);
  TSTAMP(9);

  {
    PHASE_IDS
    const bf16_t* WRZT = (const bf16_t*)(ws + OFF_WRZT);
    const int xcd = bid & 7, lid = bid >> 3, nl = nb >> 3;
    for (int sq = lid; sq < 16 * 16; sq += nl) {
      int tml, tn; raster8(sq, 16, tml, tn);
      const int tm = xcd * 16 + tml;
      const int m0 = tm * 128, n0 = tn * 128;
      auto la = [&](int kt, int row, int ch) { return ld_bf(Y0, 1024, m0 + row, kt, ch); };
      auto lb = [&](int kt, int row, int ch) { return ld_bf(WRZT, 1024, n0 + row, kt, ch); };
      f32x4 acc[4][4]; zero_acc(acc);
      gemm_tile<4, 4, true, true>(acc, 16, la, lb, smem);
#pragma unroll
      for (int i = 0; i < 4; i++) {
        const int m = m0 + wm * 64 + i * 16 + r16, nb16 = n0 + wn * 64 + quad * 16;
        const float rs = RSTD1[m];
        uint2 pk[4];
#pragma unroll
        for (int jj = 0; jj < 4; jj++) {
          f32x4 v = acc[i][jj] * rs;
          v[0] = silu_f(v[0]); v[1] = silu_f(v[1]); v[2] = silu_f(v[2]); v[3] = silu_f(v[3]);
          pk[jj] = pack4(v);
        }
        *(uint4*)(Z1 + (size_t)m * 2048 + nb16) = make_uint4(pk[0].x, pk[0].y, pk[1].x, pk[1].y);
        *(uint4*)(Z1 + (size_t)m * 2048 + nb16 + 8) = make_uint4(pk[2].x, pk[2].y, pk[3].x, pk[3].y);
      }
    }
  }
  xcd_barrier(xb);
  TSTAMP(10);

  {
    PHASE_IDS
    for (int it = gw; it < T * 4; it += nw) {
      const size_t off = (size_t)it * 512 + lane * 8;
      uint4 ov = *(const uint4*)(O1 + off);
      uint4 zv = *(const uint4*)(Z1 + off);
      float o[8] = {bflo(ov.x), bfhi(ov.x), bflo(ov.y), bfhi(ov.y), bflo(ov.z), bfhi(ov.z), bflo(ov.w), bfhi(ov.w)};
      float z[8] = {bflo(zv.x), bfhi(zv.x), bflo(zv.y), bfhi(zv.y), bflo(zv.z), bfhi(zv.z), bflo(zv.w), bfhi(zv.w)};
      float s = 0.f;
#pragma unroll
      for (int i = 0; i < 8; i++) s += o[i];
#pragma unroll
      for (int k = 32; k > 0; k >>= 1) s += __shfl_xor(s, k);
      const float mu = s * (1.f / 512.f);
      float v = 0.f;
#pragma unroll
      for (int i = 0; i < 8; i++) { o[i] -= mu; v += o[i] * o[i]; }
#pragma unroll
      for (int k = 32; k > 0; k >>= 1) v += __shfl_xor(v, k);
      const float rs = rsqrtf(v * (1.f / 512.f) + 1e-6f);
      uint4 r;
      r.x = pack2(o[0] * rs * z[0], o[1] * rs * z[1]); r.y = pack2(o[2] * rs * z[2], o[3] * rs * z[3]);
      r.z = pack2(o[4] * rs * z[4], o[5] * rs * z[5]); r.w = pack2(o[6] * rs * z[6], o[7] * rs * z[7]);
      *(uint4*)(Z1 + off) = r;
    }
  }
  xcd_barrier(xb);
  TSTAMP(11);

  {
    PHASE_IDS
    const bf16_t* WO = (const bf16_t*)(ws + OFF_WOUT1T);
    const int xcd = bid & 7, lid = bid >> 3, nl = nb >> 3;
    for (int sq = lid; sq < 16 * 8; sq += nl) {
      int tml, tn; raster8(sq, 8, tml, tn);
      const int tm = xcd * 16 + tml;
      const int m0 = tm * 128, n0 = tn * 128;
      auto la = [&](int kt, int row, int ch) {
        return kt < 32 ? ld_bf(Z1, 2048, m0 + row, kt, ch) : ld_bf(EQ1, 256, m0 + row, kt - 32, ch);
      };
      auto lb = [&](int kt, int row, int ch) { return ld_bf(WO, 2304, n0 + row, kt, ch); };
      f32x4 acc[4][4]; zero_acc(acc);
      gemm_tile<4, 4, true>(acc, 36, la, lb, smem);
#pragma unroll
      for (int i = 0; i < 4; i++)
#pragma unroll
        for (int jj = 0; jj < 4; jj++) {
          if (jj == 0) __builtin_amdgcn_sched_barrier(0);
          const int m = m0 + wm * 64 + i * 16 + r16, n = n0 + wn * 64 + jj * 16 + quad * 4;
          const uint2 yv = *(const uint2*)(Y0 + (size_t)m * 1024 + n);
          float4 r;
          r.x = bflo(yv.x) + acc[i][jj][0]; r.y = bfhi(yv.x) + acc[i][jj][1];
          r.z = bflo(yv.y) + acc[i][jj][2]; r.w = bfhi(yv.y) + acc[i][jj][3];
          *(float4*)(p.out + (size_t)m * 1024 + n) = r;
        }
    }
  }
  xcd_barrier(xb);
  TSTAMP(12);

  {
    PHASE_IDS
    for (int t = gw; t < T; t += nw) {
      float4* xp = (float4*)(p.out + (size_t)t * 1024);
      float4 v[4]; float s = 0.f;
#pragma unroll
      for (int i = 0; i < 4; i++) { v[i] = xp[lane + i * 64]; s += v[i].x * v[i].x + v[i].y * v[i].y + v[i].z * v[i].z + v[i].w * v[i].w; }
#pragma unroll
      for (int o = 32; o > 0; o >>= 1) s += __shfl_xor(s, o);
      const float rs = rsqrtf(s * (1.f / 1024.f) + 1e-6f);
#pragma unroll
      for (int i = 0; i < 4; i++) {
        const float4 gg = ((const float4*)p.fin_g)[lane + i * 64];
        v[i].x *= rs * gg.x; v[i].y *= rs * gg.y; v[i].z *= rs * gg.z; v[i].w *= rs * gg.w;
        xp[lane + i * 64] = v[i];
      }
    }
  }
  if (TSA_MASK | TSB_MASK) {
    xcd_barrier(xb);
    TSTAMP(13);
    if (blockIdx.x == 0) {
      float a = 0.f, b = 0.f;
      for (int k = 0; k < 13; k++) {
        float d = (float)(TS[k + 1] - TS[k]) * 0.00001f;
        if ((TSA_MASK >> k) & 1) a += d;
        if ((TSB_MASK >> k) & 1) b += d;
      }
      if (threadIdx.x == 0) p.out[0] += a;
      for (int i = threadIdx.x; i < 1048576; i += 256) p.out[1024 + i] += 0.1f * b;
    }
  }
}

extern "C" void kernel_launch(void* const* d_in, const int* in_sizes, int n_in,
                              void* d_out, int out_size, void* d_ws, size_t ws_size,
                              hipStream_t stream) {
  static int grid_blocks = 0;
  if (!grid_blocks) {
    int dev = 0, cus = 0, per_cu = 0;
    (void)hipGetDevice(&dev);
    (void)hipDeviceGetAttribute(&cus, hipDeviceAttributeMultiprocessorCount, dev);
    (void)hipOccupancyMaxActiveBlocksPerMultiprocessor(&per_cu, fwd_megakernel, 256, 0);
    if (per_cu < 1) per_cu = 1;
    if (per_cu > 2) per_cu = 2;
    grid_blocks = cus * per_cu;
  }
  Params p{};
  p.x = (const float*)d_in[0]; p.mem = (const float*)d_in[1]; p.pos = (const int*)d_in[2];
  p.l0_g = (const float*)d_in[3]; p.l0_win = (const float*)d_in[4]; p.l0_gb = (const float*)d_in[5];
  p.pe_k = (const float*)d_in[6]; p.w1_k = (const float*)d_in[7]; p.w2_k = (const float*)d_in[8];
  p.pe_v = (const float*)d_in[9]; p.w1_v = (const float*)d_in[10]; p.w2_v = (const float*)d_in[11];
  p.l0_wmem = (const float*)d_in[12]; p.l0_wout = (const float*)d_in[13];
  p.l1_g = (const float*)d_in[14]; p.l1_win = (const float*)d_in[15]; p.l1_wmem = (const float*)d_in[16];
  p.l1_wout = (const float*)d_in[17]; p.mem_g = (const float*)d_in[18]; p.fin_g = (const float*)d_in[19];
  p.out = (float*)d_out; p.ws = (char*)d_ws;
  (void)hipMemsetAsync((char*)d_ws + OFF_XBAR, 0, XCD_BAR_WORDS * 4, stream);
  void* args[] = {&p};
  hipError_t e = hipLaunchCooperativeKernel((void*)fwd_megakernel, dim3(grid_blocks), dim3(256), args, 0, stream);
  if (e != hipSuccess) fprintf(stderr, "cooperative launch failed: %s (grid %d)\n", hipGetErrorString(e), grid_blocks);
}
```

```cpp
#include <hip/hip_runtime.h>
#include <hip/hip_cooperative_groups.h>
#include <cstdio>
namespace cg = cooperative_groups;

typedef unsigned short bf16_t;
typedef __attribute__((ext_vector_type(8))) short bf16x8;
typedef __attribute__((ext_vector_type(4))) short s16x4;
typedef __attribute__((ext_vector_type(4))) float f32x4;
#define DI __device__ __forceinline__
#define MFMA16(a, b, c) __builtin_amdgcn_mfma_f32_16x16x32_bf16((a), (b), (c), 0, 0, 0)

#ifndef DO_L0
#define DO_L0 1
#endif
#ifndef TSA_MASK
#define TSA_MASK 0
#endif
#ifndef TSB_MASK
#define TSB_MASK 0
#endif
#define TSTAMP(k) do { if ((TSA_MASK | TSB_MASK) && blockIdx.x == 0 && threadIdx.x == 0) TS[k] = wall_clock64(); } while (0)

constexpr int T = 16384;
constexpr int TP = 16384 + 64;
constexpr int LD0 = 4480;
constexpr int C_NQ = 0, C_KCI = 512, C_VCI = 640, C_KS = 768, C_VS = 896, C_KW = 1024, C_VW = 1152, C_NZ = 1280,
              C_MQ = 1792, C_MK = 2304, C_MV = 2816, C_MZ = 3328, C_EQ = 3840, C_EZ = 4096, C_NG = 4352;
constexpr float QSCALE = 0.125f * 1.4426950408889634f;
constexpr size_t Mi = 1048576;
constexpr size_t OFF_Y0 = 0;
constexpr size_t OFF_RSTD0 = 32 * Mi;
constexpr size_t OFF_RSTD1 = OFF_RSTD0 + 65536;
constexpr size_t OFF_MEMN = OFF_RSTD1 + 65536;
constexpr size_t OFF_MEMK0 = OFF_MEMN + 524288;
constexpr size_t OFF_MEMVT0 = OFF_MEMK0 + 131072;
constexpr size_t OFF_MEMK1 = OFF_MEMVT0 + 131072;
constexpr size_t OFF_MEMVT1 = OFF_MEMK1 + 131072;
constexpr size_t OFF_WMEM0T = 33 * Mi + 512 * 1024;
constexpr size_t OFF_WMEM1T = OFF_WMEM0T + Mi;
constexpr size_t RG = 36 * Mi;
constexpr size_t OFF_WT0 = RG;
constexpr size_t OFF_WOUT0T = RG + 9 * Mi;
constexpr size_t OFF_W1KT = RG + 12 * Mi;
constexpr size_t OFF_W1VT = OFF_W1KT + 262144;
constexpr size_t OFF_W2KT = OFF_W1VT + 262144;
constexpr size_t OFF_W2VT = OFF_W2KT + 8192;
constexpr size_t OFF_CBIAS = OFF_W2VT + 8192;
constexpr size_t OFF_KMEAN = OFF_CBIAS + 1024;
constexpr size_t OFF_KC = RG + 13 * Mi;
constexpr size_t OFF_VCT = OFF_KC + 262144;
constexpr size_t OFF_HID = OFF_VCT + 262144;
constexpr size_t OFF_ROPE0C = RG + 14 * Mi;
constexpr size_t OFF_ROPE0S = RG + 16 * Mi;
constexpr size_t OFF_NG = RG + 18 * Mi;
constexpr size_t OFF_VST = RG + 20 * Mi;
constexpr size_t OFF_VWT = RG + 25 * Mi;
constexpr size_t OFF_MVT = RG + 30 * Mi;
constexpr size_t OFF_PR0 = RG + 47 * Mi;
constexpr size_t OFF_WRZT = RG;
constexpr size_t OFF_WOUT1T = RG + 4 * Mi;
constexpr size_t OFF_EQ1 = RG + 9 * Mi;
constexpr size_t OFF_EZ1 = RG + 17 * Mi;
constexpr size_t OFF_KP = RG + 25 * Mi;
constexpr size_t OFF_KPT = RG + 57 * Mi;
constexpr size_t OFF_O = OFF_KP;
constexpr size_t OFF_VT = RG + 89 * Mi + 512 * 1024;
constexpr size_t OFF_Z = OFF_VT;
constexpr size_t OFF_S = RG + 154 * Mi + 512 * 1024;
constexpr size_t OFF_ROPE1C = OFF_S;
constexpr size_t OFF_ROPE1S = OFF_S + 8 * Mi;
constexpr size_t OFF_WT1 = OFF_S + 16 * Mi;
constexpr size_t OFF_XB1 = OFF_S + 25 * Mi;
constexpr size_t OFF_XB0 = 0;
constexpr size_t OFF_PARTA = 223 * Mi;
constexpr size_t OFF_PARTB = 0;
constexpr size_t PART_HEAD = 6 * Mi;
constexpr size_t OFF_LSESEL = 253 * Mi;
constexpr size_t OFF_LSEOWN = 253 * Mi + 1536 * 1024;
constexpr size_t OFF_CNT = 33 * Mi + 262144 + 1024;
constexpr size_t OFF_XBAR = 33 * Mi + 262144 + 16384;
constexpr size_t DOFF_BUCKET = 40 * Mi;
constexpr int BUCKET_HEAD = 516096;
constexpr size_t DOFF_P = 32 * Mi;

struct Params {
  const float* x; const float* mem; const int* pos;
  const float *l0_g, *l0_win, *l0_gb, *pe_k, *w1_k, *w2_k, *pe_v, *w1_v, *w2_v, *l0_wmem, *l0_wout;
  const float *l1_g, *l1_win, *l1_wmem, *l1_wout, *mem_g, *fin_g;
  float* out; char* ws;
};

DI bf16_t f2bf(float f) { unsigned u = __float_as_uint(f); u += 0x7fffu + ((u >> 16) & 1u); return (bf16_t)(u >> 16); }
DI float bf2f(bf16_t h) { return __uint_as_float(((unsigned)h) << 16); }
typedef __bf16 bf2_t __attribute__((ext_vector_type(2)));
typedef float f2_t __attribute__((ext_vector_type(2)));
DI unsigned pack2(float a, float b) { f2_t v = {a, b}; bf2_t r = __builtin_convertvector(v, bf2_t); return __builtin_bit_cast(unsigned, r); }
DI float bflo(unsigned u) { return __uint_as_float(u << 16); }
DI float bfhi(unsigned u) { return __uint_as_float(u & 0xffff0000u); }
DI float silu_f(float x) { return x / (1.f + __expf(-x)); }
DI float sigm_f(float x) { return 1.f / (1.f + __expf(-x)); }
DI float ex2(float x) { return __builtin_amdgcn_exp2f(x); }
DI void wave_lds_sync() { asm volatile("s_waitcnt lgkmcnt(0)" ::: "memory"); }
DI uint2 pack4(f32x4 v) { uint2 r; r.x = pack2(v[0], v[1]); r.y = pack2(v[2], v[3]); return r; }

template <int WM, int WN, bool SWAP, class LA, class LB>
DI void gemm_tile(f32x4 (&acc)[WM][WN], int nk, LA loadA, LB loadB, bf16_t* smem) {
  constexpr int BM = WM * 32, BN = WN * 32, LD = 80, NA = BM / 32, NB = BN / 32;
  bf16_t* sA = smem;
  bf16_t* sB = smem + 2 * BM * LD;
  int tid = threadIdx.x;
  asm volatile("" : "+v"(tid));
  const int lane = tid & 63, wave = tid >> 6, wm = wave >> 1, wn = wave & 1;
  const int r16 = lane & 15, quad = lane >> 4;
  uint4 ra0[NA], rb0[NB], ra1[NA], rb1[NB];
#define GT_LOAD(RA, RB, KT)                                                                          \
  {                                                                                                  \
    _Pragma("unroll") for (int i = 0; i < NA; i++) { int idx = tid + i * 256; RA[i] = loadA((KT), idx >> 3, idx & 7); } \
    _Pragma("unroll") for (int i = 0; i < NB; i++) { int idx = tid + i * 256; RB[i] = loadB((KT), idx >> 3, idx & 7); } \
    __builtin_amdgcn_sched_barrier(0);                                                               \
  }
#define GT_STORE(RA, RB, BUF)                                                                        \
  {                                                                                                  \
    __builtin_amdgcn_sched_barrier(0);                                                               \
    bf16_t* sAn = sA + (BUF) * BM * LD; bf16_t* sBn = sB + (BUF) * BN * LD;                           \
    _Pragma("unroll") for (int i = 0; i < NA; i++) { int idx = tid + i * 256; *(uint4*)(sAn + (idx >> 3) * LD + (idx & 7) * 8) = RA[i]; } \
    _Pragma("unroll") for (int i = 0; i < NB; i++) { int idx = tid + i * 256; *(uint4*)(sBn + (idx >> 3) * LD + (idx & 7) * 8) = RB[i]; } \
  }
#define GT_COMPUTE(BUF)                                                                              \
  {                                                                                                  \
    const bf16_t* ab = sA + (BUF) * BM * LD + (wm * WM * 16 + r16) * LD + quad * 8;                   \
    const bf16_t* bb = sB + (BUF) * BN * LD + (wn * WN * 16 + r16) * LD + quad * 8;                   \
    __builtin_amdgcn_s_setprio(1);     \
    _Pragma("unroll") for (int kk = 0; kk < 2; kk++) {                                               \
      bf16x8 af[WM], bfr[WN];                                                                        \
      _Pragma("unroll") for (int i = 0; i < WM; i++) af[i] = *(const bf16x8*)(ab + i * 16 * LD + kk * 32);  \
      _Pragma("unroll") for (int j = 0; j < WN; j++) bfr[j] = *(const bf16x8*)(bb + j * 16 * LD + kk * 32); \
      _Pragma("unroll") for (int i = 0; i < WM; i++)                                                 \
        _Pragma("unroll") for (int j = 0; j < WN; j++)                                               \
          acc[i][j] = SWAP ? MFMA16(bfr[j], af[i], acc[i][j]) : MFMA16(af[i], bfr[j], acc[i][j]);    \
    }                                                                                                \
    __builtin_amdgcn_s_setprio(0);                                                                   \
  }
  GT_LOAD(ra0, rb0, 0);
  if (nk > 1) GT_LOAD(ra1, rb1, 1);
  GT_STORE(ra0, rb0, 0);
  __syncthreads();
  for (int kt = 0; kt < nk; kt += 2) {
    if (kt + 2 < nk) GT_LOAD(ra0, rb0, kt + 2);
    GT_COMPUTE(0);
    if (kt + 1 < nk) GT_STORE(ra1, rb1, 1);
    __syncthreads();
    if (kt + 1 >= nk) break;
    if (kt + 3 < nk) GT_LOAD(ra1, rb1, kt + 3);
    GT_COMPUTE(1);
    if (kt + 2 < nk) GT_STORE(ra0, rb0, 0);
    __syncthreads();
  }
#undef GT_LOAD
#undef GT_STORE
#undef GT_COMPUTE
}

template <int WM, int WN>
DI void zero_acc(f32x4 (&acc)[WM][WN]) {
#pragma unroll
  for (int i = 0; i < WM; i++)
#pragma unroll
    for (int j = 0; j < WN; j++) acc[i][j] = (f32x4){0.f, 0.f, 0.f, 0.f};
}

DI uint4 ld_bf(const bf16_t* base, size_t ld, int row, int kt, int ch) {
  return *(const uint4*)(base + (size_t)row * ld + kt * 64 + ch * 8);
}
DI uint4 ld_x(const float* x, const bf16_t* y0, int t, int kt, int ch) {
  const int k = kt * 64 + ch * 8;
  const float4* xp = (const float4*)(x + (size_t)t * 1024 + k);
  float4 a = xp[0], b = xp[1];
  if (y0) {
    uint4 yv = *(const uint4*)(y0 + (size_t)t * 1024 + k);
    a.x += bflo(yv.x); a.y += bfhi(yv.x); a.z += bflo(yv.y); a.w += bfhi(yv.y);
    b.x += bflo(yv.z); b.y += bfhi(yv.z); b.z += bflo(yv.w); b.w += bfhi(yv.w);
  }
  uint4 r;
  r.x = pack2(a.x, a.y); r.y = pack2(a.z, a.w); r.z = pack2(b.x, b.y); r.w = pack2(b.z, b.w);
  return r;
}

template <class CM>
DI void transpose_w(const float* src, int K, int srcN, bf16_t* dst, int Npad, CM cm, float* sm, int bid, int nb, const float* gk = nullptr) {
  int tid = threadIdx.x;
  asm volatile("" : "+v"(tid));
  const int tx = tid & 63, ty = tid >> 6;
  const int tilesK = K / 64, tilesN = Npad / 64;
  for (int it = bid; it < tilesK * tilesN; it += nb) {
    const int n0 = (it / tilesK) * 64, k0 = (it % tilesK) * 64;
    const int sc = cm(n0 + tx);
#pragma unroll 4
    for (int i = 0; i < 16; i++) {
      int kk = ty + i * 4;
      sm[kk * 65 + tx] = sc >= 0 ? src[(size_t)(k0 + kk) * srcN + sc] : 0.f;
    }
    __syncthreads();
#pragma unroll 4
    for (int i = 0; i < 16; i++) {
      int nn = ty + i * 4;
      dst[(size_t)(n0 + nn) * K + k0 + tx] = f2bf(sm[tx * 65 + nn] * (gk ? gk[k0 + tx] : 1.f));
    }
    __syncthreads();
  }
}

DI void row_rstd(const float* x, const bf16_t* y0, float* rstd, bf16_t* xb, int rows, int gw, int nw, int lane) {
  for (int t = gw; t < rows; t += nw) {
    const float4* xp = (const float4*)(x + (size_t)t * 1024);
    float s = 0.f;
#pragma unroll
    for (int i = 0; i < 4; i++) {
      float4 v = xp[lane + i * 64];
      if (y0) {
        uint2 yv = *(const uint2*)(y0 + (size_t)t * 1024 + (lane + i * 64) * 4);
        v.x += bflo(yv.x); v.y += bfhi(yv.x); v.z += bflo(yv.y); v.w += bfhi(yv.y);
      }
      s += v.x * v.x + v.y * v.y + v.z * v.z + v.w * v.w;
      uint2 o; o.x = pack2(v.x, v.y); o.y = pack2(v.z, v.w);
      *(uint2*)(xb + (size_t)t * 1024 + (lane + i * 64) * 4) = o;
    }
#pragma unroll
    for (int o = 32; o > 0; o >>= 1) s += __shfl_xor(s, o);
    if (lane == 0) rstd[t] = rsqrtf(s * (1.f / 1024.f) + 1e-6f);
  }
}

struct AttnSt { float m, l; f32x4 o[4]; };
DI void attn_init(AttnSt& s) {
  s.m = -1e30f; s.l = 0.f;
#pragma unroll
  for (int i = 0; i < 4; i++) s.o[i] = (f32x4){0.f, 0.f, 0.f, 0.f};
}
DI f32x4 qk16(const bf16_t* K, int ks, int key0, bf16x8 q0, bf16x8 q1, int lane) {
  const bf16_t* kp = K + (size_t)(key0 + (lane & 15)) * ks + (lane >> 4) * 8;
  bf16x8 k0 = *(const bf16x8*)kp;
  bf16x8 k1 = *(const bf16x8*)(kp + 32);
  f32x4 s = {0.f, 0.f, 0.f, 0.f};
  s = MFMA16(k0, q0, s);
  s = MFMA16(k1, q1, s);
  return s;
}
DI f32x4 qk16p(const bf16_t* K, int ks, int key0, int half, bf16x8 q0, bf16x8 q1, int lane) {
  const int r16 = lane & 15;
  const bf16_t* kp = K + (size_t)(key0 + (r16 >> 2) * 8 + (r16 & 3) + half * 4) * ks + (lane >> 4) * 8;
  bf16x8 k0 = *(const bf16x8*)kp;
  bf16x8 k1 = *(const bf16x8*)(kp + 32);
  f32x4 s = {0.f, 0.f, 0.f, 0.f};
  s = MFMA16(k0, q0, s);
  s = MFMA16(k1, q1, s);
  return s;
}
template <class MF>
DI void attn_step(const bf16_t* K, int ks, const bf16_t* Vt, int vs, int key0, bf16x8 q0, bf16x8 q1, AttnSt& st,
                  MF maskf, int lane) {
  const int r16 = lane & 15, quad = lane >> 4;
  f32x4 sa = qk16p(K, ks, key0, 0, q0, q1, lane);
  f32x4 sb = qk16p(K, ks, key0, 1, q0, q1, lane);
  const bf16_t* vp = Vt + (size_t)r16 * vs + key0 + quad * 8;
  bf16x8 vf[4];
#pragma unroll
  for (int dt = 0; dt < 4; dt++) vf[dt] = *(const bf16x8*)(vp + (size_t)dt * 16 * vs);
  bool ma[4], mb[4];
  float lm = -1e30f;
#pragma unroll
  for (int r = 0; r < 4; r++) {
    ma[r] = maskf(key0 + quad * 8 + r);
    mb[r] = maskf(key0 + quad * 8 + 4 + r);
    if (ma[r]) lm = fmaxf(lm, sa[r]);
    if (mb[r]) lm = fmaxf(lm, sb[r]);
  }
  if (__ballot(lm > st.m + 8.f) != 0ull) {
    float mx = fmaxf(lm, __shfl_xor(lm, 16));
    mx = fmaxf(mx, __shfl_xor(mx, 32));
    const float mn = (mx > st.m + 8.f) ? mx : st.m;
    const float alpha = ex2(st.m - mn);
    st.l *= alpha;
    st.m = mn;
#pragma unroll
    for (int dt = 0; dt < 4; dt++) st.o[dt] *= alpha;
  }
  float pa[4], pb[4], rs = 0.f;
#pragma unroll
  for (int r = 0; r < 4; r++) {
    pa[r] = ma[r] ? ex2(sa[r] - st.m) : 0.f;
    pb[r] = mb[r] ? ex2(sb[r] - st.m) : 0.f;
    rs += pa[r] + pb[r];
  }
  st.l += rs;
  uint4 pu;
  pu.x = pack2(pa[0], pa[1]); pu.y = pack2(pa[2], pa[3]); pu.z = pack2(pb[0], pb[1]); pu.w = pack2(pb[2], pb[3]);
  const bf16x8 pf = __builtin_bit_cast(bf16x8, pu);
#pragma unroll
  for (int dt = 0; dt < 4; dt++) st.o[dt] = MFMA16(vf[dt], pf, st.o[dt]);
}
template <class MF>
DI void attn_compute64(const bf16x8 (&kf)[8], const bf16x8 (&vf)[8], int key0, bf16x8 q0, bf16x8 q1, AttnSt& st, MF maskf, int lane) {
  const int quad = lane >> 4;
  f32x4 sc4[4];
#pragma unroll
  for (int j = 0; j < 4; j++) {
    f32x4 z = {0.f, 0.f, 0.f, 0.f};
    z = MFMA16(kf[(j >> 1) * 4 + (j & 1) * 2 + 0], q0, z);
    sc4[j] = MFMA16(kf[(j >> 1) * 4 + (j & 1) * 2 + 1], q1, z);
  }
  bool mk[4][4];
  float lm = -1e30f;
#pragma unroll
  for (int j = 0; j < 4; j++)
#pragma unroll
    for (int r = 0; r < 4; r++) {
      mk[j][r] = maskf(key0 + (j >> 1) * 32 + quad * 8 + (j & 1) * 4 + r);
      if (mk[j][r]) lm = fmaxf(lm, sc4[j][r]);
    }
  if (__ballot(lm > st.m + 8.f) != 0ull) {
    float mx = fmaxf(lm, __shfl_xor(lm, 16));
    mx = fmaxf(mx, __shfl_xor(mx, 32));
    const float mn = (mx > st.m + 8.f) ? mx : st.m;
    const float alpha = ex2(st.m - mn);
    st.l *= alpha;
    st.m = mn;
#pragma unroll
    for (int dt = 0; dt < 4; dt++) st.o[dt] *= alpha;
  }
  float pv[4][4], rs = 0.f;
#pragma unroll
  for (int j = 0; j < 4; j++)
#pragma unroll
    for (int r = 0; r < 4; r++) { pv[j][r] = mk[j][r] ? ex2(sc4[j][r] - st.m) : 0.f; rs += pv[j][r]; }
  st.l += rs;
#pragma unroll
  for (int hb = 0; hb < 2; hb++) {
    uint4 pu;
    pu.x = pack2(pv[hb * 2][0], pv[hb * 2][1]); pu.y = pack2(pv[hb * 2][2], pv[hb * 2][3]);
    pu.z = pack2(pv[hb * 2 + 1][0], pv[hb * 2 + 1][1]); pu.w = pack2(pv[hb * 2 + 1][2], pv[hb * 2 + 1][3]);
    const bf16x8 pf = __builtin_bit_cast(bf16x8, pu);
#pragma unroll
    for (int dt = 0; dt < 4; dt++) st.o[dt] = MFMA16(vf[hb * 4 + dt], pf, st.o[dt]);
  }
}
template <class MF>
DI void attn_step64(const bf16_t* K, int ks, const bf16_t* Vt, int vs, int key0, bf16x8 q0, bf16x8 q1, AttnSt& st,
                    MF maskf, int lane) {
  const int r16 = lane & 15, quad = lane >> 4;
  const bf16_t* kp = K + (size_t)(key0 + (r16 >> 2) * 8 + (r16 & 3)) * ks + quad * 8;
  bf16x8 kf[8];
#pragma unroll
  for (int hb = 0; hb < 2; hb++) {
    const bf16_t* kq = kp + (size_t)hb * 32 * ks;
    kf[hb * 4 + 0] = *(const bf16x8*)kq; kf[hb * 4 + 1] = *(const bf16x8*)(kq + 32);
    kf[hb * 4 + 2] = *(const bf16x8*)(kq + (size_t)4 * ks); kf[hb * 4 + 3] = *(const bf16x8*)(kq + (size_t)4 * ks + 32);
  }
  const bf16_t* vp = Vt + (size_t)r16 * vs + key0 + quad * 8;
  bf16x8 vf[8];
#pragma unroll
  for (int dt = 0; dt < 4; dt++) { vf[dt] = *(const bf16x8*)(vp + (size_t)dt * 16 * vs); vf[4 + dt] = *(const bf16x8*)(vp + (size_t)dt * 16 * vs + 32); }
  attn_compute64(kf, vf, key0, q0, q1, st, maskf, lane);
}
template <class MF>
DI void attn_block_lds(const bf16_t* K, int ks, const bf16_t* Vt, int vs, int key0, bf16x8 q0, bf16x8 q1, AttnSt& st,
                       MF maskf, char* stage, int lane) {
  const int r16 = lane & 15, quad = lane >> 4;
  const int rsub = lane >> 3, ch = lane & 7;
  {
    uint4 tk[8];
#pragma unroll
    for (int i = 0; i < 8; i++) tk[i] = *(const uint4*)(K + (size_t)(key0 + i * 8 + rsub) * ks + ch * 8);
    uint4 tv[4];
#pragma unroll
    for (int i = 0; i < 4; i++) tv[i] = *(const uint4*)(Vt + (size_t)(i * 8 + rsub) * vs + key0 + ch * 8);
#pragma unroll
    for (int i = 0; i < 8; i++) *(uint4*)(stage + (i * 8 + rsub) * 144 + ch * 16) = tk[i];
#pragma unroll
    for (int i = 0; i < 4; i++) tk[i] = *(const uint4*)(Vt + (size_t)((i + 4) * 8 + rsub) * vs + key0 + ch * 8);
#pragma unroll
    for (int i = 0; i < 4; i++) *(uint4*)(stage + 9216 + (i * 8 + rsub) * 144 + ch * 16) = tv[i];
#pragma unroll
    for (int i = 0; i < 4; i++) *(uint4*)(stage + 9216 + ((i + 4) * 8 + rsub) * 144 + ch * 16) = tk[i];
  }
  wave_lds_sync();
  bf16x8 kf[8], vf[8];
  const char* kb = stage + ((r16 >> 2) * 8 + (r16 & 3)) * 144 + quad * 16;
#pragma unroll
  for (int hb = 0; hb < 2; hb++) {
    kf[hb * 4 + 0] = *(const bf16x8*)(kb + hb * 32 * 144);
    kf[hb * 4 + 1] = *(const bf16x8*)(kb + hb * 32 * 144 + 64);
    kf[hb * 4 + 2] = *(const bf16x8*)(kb + (hb * 32 + 4) * 144);
    kf[hb * 4 + 3] = *(const bf16x8*)(kb + (hb * 32 + 4) * 144 + 64);
  }
  const char* vb = stage + 9216 + r16 * 144 + quad * 16;
#pragma unroll
  for (int dt = 0; dt < 4; dt++) { vf[dt] = *(const bf16x8*)(vb + dt * 16 * 144); vf[4 + dt] = *(const bf16x8*)(vb + dt * 16 * 144 + 64); }
  wave_lds_sync();
  attn_compute64(kf, vf, key0, q0, q1, st, maskf, lane);
}
DI void attn_finish(AttnSt& st) {
  st.l += __shfl_xor(st.l, 16);
  st.l += __shfl_xor(st.l, 32);
}
DI void load_q(const bf16_t* qrow, int lane, bf16x8& q0, bf16x8& q1) {
  q0 = *(const bf16x8*)(qrow + (lane >> 4) * 8);
  q1 = *(const bf16x8*)(qrow + 32 + (lane >> 4) * 8);
}

DI void mem_attn_item(const bf16_t* qsrc, int qld, const bf16_t* zsrc, int zld, bf16_t* dst, int dld,
                      const bf16_t* memK, const bf16_t* memVT, int t0, int h, int lane, char* stage) {
  const int r16 = lane & 15, quad = lane >> 4;
  const int t = t0 + r16;
  bf16x8 q0, q1;
  load_q(qsrc + (size_t)t * qld + h * 64, lane, q0, q1);
  AttnSt st; attn_init(st);
  for (int key0 = 0; key0 < 256; key0 += 64)
    attn_block_lds(memK + h * 64, 256, memVT + (size_t)h * 64 * 256, 256, key0, q0, q1, st, [](int) { return true; }, stage, lane);
  attn_finish(st);
  const float inv = 1.f / fmaxf(st.l, 1e-30f);
#pragma unroll
  for (int dt = 0; dt < 4; dt++) {
    const int d = dt * 16 + quad * 4;
    uint2 zv = *(const uint2*)(zsrc + (size_t)t * zld + h * 64 + d);
    f32x4 o = st.o[dt];
    uint2 r;
    r.x = pack2(o[0] * inv * bflo(zv.x), o[1] * inv * bfhi(zv.x));
    r.y = pack2(o[2] * inv * bflo(zv.y), o[3] * inv * bfhi(zv.y));
    *(uint2*)(dst + (size_t)t * dld + h * 64 + d) = r;
  }
}

DI void moba_item(const bf16_t* PR0, const bf16_t* MVT, const bf16_t* KMEAN, bf16_t* CAT0, int* CNT, int* BUCKET,
                  float* LSESEL, float* LSEOWN, int t0, int h, int lane, char* stage) {
  const int r16 = lane & 15, quad = lane >> 4;
  const int t = t0 + r16;
  const int cur = t0 >> 8;
  bf16x8 q0, q1;
  load_q(PR0 + (size_t)t * LD0 + C_MQ + h * 64, lane, q0, q1);
  unsigned long long k1 = 0, k2 = 0, k3 = 0;
  auto ins = [&](unsigned long long k) {
    unsigned long long a = k1 > k ? k1 : k, r = k1 > k ? k : k1;
    k1 = a;
    a = k2 > r ? k2 : r; r = k2 > r ? r : k2;
    k2 = a;
    k3 = k3 > r ? k3 : r;
  };
  if (cur > 0) {
#pragma unroll
    for (int kt = 0; kt < 4; kt++) {
      f32x4 s = qk16(KMEAN + h * 64, 512, kt * 16, q0, q1, lane);
#pragma unroll
      for (int r = 0; r < 4; r++) {
        const int n = kt * 16 + quad * 4 + r;
        unsigned u = __float_as_uint(s[r]);
        u = (u & 0x80000000u) ? ~u : (u | 0x80000000u);
        unsigned long long key = (((unsigned long long)u) << 8) | (unsigned)(63 - n);
        if (n < cur) ins(key);
      }
    }
#pragma unroll
    for (int off = 16; off <= 32; off <<= 1) {
      unsigned long long o1, o2, o3;
      o1 = ((unsigned long long)__shfl_xor((unsigned)(k1 >> 32), off) << 32) | __shfl_xor((unsigned)k1, off);
      o2 = ((unsigned long long)__shfl_xor((unsigned)(k2 >> 32), off) << 32) | __shfl_xor((unsigned)k2, off);
      o3 = ((unsigned long long)__shfl_xor((unsigned)(k3 >> 32), off) << 32) | __shfl_xor((unsigned)k3, off);
      ins(o1); ins(o2); ins(o3);
    }
  }
  if (quad == 0) {
#pragma unroll
    for (int k = 0; k < 3; k++) {
      const unsigned long long kk = k == 0 ? k1 : (k == 1 ? k2 : k3);
      if (kk) {
        const int n = 63 - (int)(kk & 0xff);
        const int slot = atomicAdd(CNT + h * 64 + n, 1);
        BUCKET[(size_t)h * BUCKET_HEAD + n * T - 128 * n * (n + 1) + slot] = (t << 2) | k;
      } else {
        LSESEL[((size_t)t * 8 + h) * 3 + k] = -1e30f;
      }
    }
  }
  AttnSt st; attn_init(st);
  const bf16_t* Kb = PR0 + C_MK + h * 64;
  const bf16_t* Vb = MVT + (size_t)h * 64 * TP;
  for (int key0 = cur * 256; key0 <= t0 + 15; key0 += 64)
    attn_block_lds(Kb, LD0, Vb, TP, key0, q0, q1, st, [&](int key) { return key <= t; }, stage, lane);
  attn_finish(st);
  const float inv = 1.f / fmaxf(st.l, 1e-30f);
#pragma unroll
  for (int dt = 0; dt < 4; dt++) {
    const int d = dt * 16 + quad * 4;
    *(uint2*)(CAT0 + (size_t)t * 1280 + 512 + h * 64 + d) = pack4(st.o[dt] * inv);
  }
  if (quad == 0) LSEOWN[(size_t)t * 8 + h] = st.m + log2f(fmaxf(st.l, 1e-30f));
}

DI void moba_bucket_item(const bf16_t* PR0, const bf16_t* MVT, const int* BUCKET, char* ws, float* LSESEL,
                         int h, int n, int e0, int count, int lane) {
  const int r16 = lane & 15, quad = lane >> 4;
  const int* bk = BUCKET + (size_t)h * BUCKET_HEAD + n * T - 128 * n * (n + 1);
  bf16x8 q0[4], q1[4];
  int ent[4];
  AttnSt st[4];
#pragma unroll
  for (int ct = 0; ct < 4; ct++) {
    const int e = e0 + ct * 16 + r16;
    ent[ct] = e < count ? bk[e] : -1;
    const int t = ent[ct] >= 0 ? (ent[ct] >> 2) : 0;
    load_q(PR0 + (size_t)t * LD0 + C_MQ + h * 64, lane, q0[ct], q1[ct]);
    attn_init(st[ct]);
  }
  const bf16_t* Kb = PR0 + C_MK + h * 64;
  const bf16_t* Vb = MVT + (size_t)h * 64 * TP;
  for (int key0 = n * 256; key0 < n * 256 + 256; key0 += 32) {
    const bf16_t* kp = Kb + (size_t)(key0 + (r16 >> 2) * 8 + (r16 & 3)) * LD0 + quad * 8;
    const bf16x8 ka0 = *(const bf16x8*)kp, ka1 = *(const bf16x8*)(kp + 32);
    const bf16x8 kb0 = *(const bf16x8*)(kp + (size_t)4 * LD0), kb1 = *(const bf16x8*)(kp + (size_t)4 * LD0 + 32);
    const bf16_t* vp = Vb + (size_t)r16 * TP + key0 + quad * 8;
    bf16x8 vf[4];
#pragma unroll
    for (int dt = 0; dt < 4; dt++) vf[dt] = *(const bf16x8*)(vp + (size_t)dt * 16 * TP);
#pragma unroll
    for (int ct = 0; ct < 4; ct++) {
      f32x4 sa = {0.f, 0.f, 0.f, 0.f}, sb = {0.f, 0.f, 0.f, 0.f};
      sa = MFMA16(ka0, q0[ct], sa); sa = MFMA16(ka1, q1[ct], sa);
      sb = MFMA16(kb0, q0[ct], sb); sb = MFMA16(kb1, q1[ct], sb);
      const float lm = fmaxf(fmaxf(fmaxf(sa[0], sa[1]), fmaxf(sa[2], sa[3])), fmaxf(fmaxf(sb[0], sb[1]), fmaxf(sb[2], sb[3])));
      if (__ballot(lm > st[ct].m + 8.f) != 0ull) {
        float mx = fmaxf(lm, __shfl_xor(lm, 16));
        mx = fmaxf(mx, __shfl_xor(mx, 32));
        const float mn = (mx > st[ct].m + 8.f) ? mx : st[ct].m;
        const float alpha = ex2(st[ct].m - mn);
        st[ct].l *= alpha;
        st[ct].m = mn;
#pragma unroll
        for (int dt = 0; dt < 4; dt++) st[ct].o[dt] *= alpha;
      }
      f32x4 pa, pb;
#pragma unroll
      for (int r = 0; r < 4; r++) { pa[r] = ex2(sa[r] - st[ct].m); pb[r] = ex2(sb[r] - st[ct].m); }
      st[ct].l += (pa[0] + pa[1]) + (pa[2] + pa[3]) + (pb[0] + pb[1]) + (pb[2] + pb[3]);
      uint4 pu;
      pu.x = pack2(pa[0], pa[1]); pu.y = pack2(pa[2], pa[3]); pu.z = pack2(pb[0], pb[1]); pu.w = pack2(pb[2], pb[3]);
      const bf16x8 pf = __builtin_bit_cast(bf16x8, pu);
#pragma unroll
      for (int dt = 0; dt < 4; dt++) st[ct].o[dt] = MFMA16(vf[dt], pf, st[ct].o[dt]);
    }
  }
#pragma unroll
  for (int ct = 0; ct < 4; ct++) attn_finish(st[ct]);
  bf16_t* part = (bf16_t*)(ws + (h < 5 ? OFF_PARTA + (size_t)h * PART_HEAD : OFF_PARTB + (size_t)(h - 5) * PART_HEAD));
#pragma unroll
  for (int ct = 0; ct < 4; ct++) {
    if (ent[ct] < 0) continue;
    const int t = ent[ct] >> 2, k = ent[ct] & 3;
    const float inv = 1.f / fmaxf(st[ct].l, 1e-30f);
#pragma unroll
    for (int dt = 0; dt < 4; dt++)
      *(uint2*)(part + ((size_t)t * 3 + k) * 64 + dt * 16 + quad * 4) = pack4(st[ct].o[dt] * inv);
    if (quad == 0) LSESEL[((size_t)t * 8 + h) * 3 + k] = st[ct].m + log2f(fmaxf(st[ct].l, 1e-30f));
  }
}

DI void nsa_item(const bf16_t* PR0, const bf16_t* KC, const bf16_t* VCT, const bf16_t* VST, const bf16_t* VWT,
                 const float* NG, bf16_t* CAT0, int t0, int g, float* impw, unsigned* selw, int lane) {
  char* stage = (char*)impw;
  const int r16 = lane & 15, quad = lane >> 4;
  const int ql = r16 >> 2, hd = r16 & 3, H = g * 4 + hd;
  const int t = t0 + ql;
  const int cur = t0 >> 6;
  bf16x8 q0, q1;
  load_q(PR0 + (size_t)t * LD0 + C_NQ + H * 64, lane, q0, q1);
  const int nmax = (t >= 31) ? ((t - 31) >> 4) : -1;
  const int nmax_tile = (t0 + 3 >= 31) ? ((t0 + 3 - 31) >> 4) : -1;
  const bf16_t* Kc = KC + g * 64;
  const bf16_t* Vc = VCT + (size_t)g * 64 * 1024;
  AttnSt sc; attn_init(sc);
  for (int key0 = 0; key0 <= nmax_tile; key0 += 64)
    attn_block_lds(Kc, 128, Vc, 1024, key0, q0, q1, sc, [&](int n) { return n <= nmax; }, stage, lane);
  attn_finish(sc);
  if (cur >= 3) {
    const float invl = 1.f / fmaxf(sc.l, 1e-30f);
    float carry = 0.f;
    char* kst = stage + 9216;
    for (int key0 = 0; key0 <= nmax_tile; key0 += 32) {
      if ((key0 & 32) == 0) {
        wave_lds_sync();
        const int rsub = lane >> 3, ch = lane & 7;
        uint4 tk[8];
#pragma unroll
        for (int i = 0; i < 8; i++) tk[i] = *(const uint4*)(Kc + (size_t)(key0 + i * 8 + rsub) * 128 + ch * 8);
#pragma unroll
        for (int i = 0; i < 8; i++) *(uint4*)(kst + (i * 8 + rsub) * 144 + ch * 16) = tk[i];
        wave_lds_sync();
      }
      const char* kp = kst + ((key0 & 32) + (r16 >> 2) * 8 + (r16 & 3)) * 144 + quad * 16;
      f32x4 sa = {0.f, 0.f, 0.f, 0.f}, sb = {0.f, 0.f, 0.f, 0.f};
      sa = MFMA16(*(const bf16x8*)kp, q0, sa); sa = MFMA16(*(const bf16x8*)(kp + 64), q1, sa);
      sb = MFMA16(*(const bf16x8*)(kp + 4 * 144), q0, sb); sb = MFMA16(*(const bf16x8*)(kp + 4 * 144 + 64), q1, sb);
      float xa = 0.f, xb = 0.f, ea = 0.f, eb = 0.f;
#pragma unroll
      for (int r = 0; r < 4; r++) {
        float pa = (key0 + quad * 8 + r <= nmax) ? ex2(sa[r] - sc.m) * invl : 0.f;
        float pb = (key0 + quad * 8 + 4 + r <= nmax) ? ex2(sb[r] - sc.m) * invl : 0.f;
        xa += pa; xb += pb;
        if (r == 3) { ea = pa; eb = pb; }
      }
      const float eb_up = __shfl(eb, (lane - 16) & 63);
      const float eb_q3 = __shfl(eb, r16 + 48);
      float ia = xa + (quad > 0 ? eb_up : carry);
      float ib = xb + ea;
      carry = eb_q3;
      ia += __shfl_xor(ia, 1); ia += __shfl_xor(ia, 2);
      ib += __shfl_xor(ib, 1); ib += __shfl_xor(ib, 2);
      if (hd == 0) {
        impw[ql * 256 + (key0 >> 2) + 2 * quad] = ia;
        impw[ql * 256 + (key0 >> 2) + 2 * quad + 1] = ib;
      }
    }
  }
  wave_lds_sync();
  {
    const int nforced = cur == 0 ? 1 : (cur == 1 ? 2 : 3);
    const int R = 16 - nforced;
    const int hi = cur - 2;
    const int cnt = hi >= 1 ? hi : 0;
    const int sb = lane * 4;
    f32x4 vq[4];
    unsigned nib[4];
#pragma unroll
    for (int qq = 0; qq < 4; qq++) {
      vq[qq] = (f32x4){-1.f, -1.f, -1.f, -1.f};
      nib[qq] = 0u;
      if (cnt > 0) {
        const f32x4 iv = *(const f32x4*)(impw + qq * 256 + sb);
#pragma unroll
        for (int i = 0; i < 4; i++) if (sb + i >= 1 && sb + i <= hi) vq[qq][i] = iv[i];
      }
    }
    if (cnt <= R) {
#pragma unroll
      for (int qq = 0; qq < 4; qq++)
        nib[qq] = (vq[qq][0] >= 0.f ? 1u : 0u) | (vq[qq][1] >= 0.f ? 2u : 0u) | (vq[qq][2] >= 0.f ? 4u : 0u) | (vq[qq][3] >= 0.f ? 8u : 0u);
    } else {
      for (int round = 0; round < R; round++) {
        unsigned kh[4], kl[4];
#pragma unroll
        for (int qq = 0; qq < 4; qq++) {
          float bv = vq[qq][0]; int bi = 0;
          if (vq[qq][1] > bv) { bv = vq[qq][1]; bi = 1; }
          if (vq[qq][2] > bv) { bv = vq[qq][2]; bi = 2; }
          if (vq[qq][3] > bv) { bv = vq[qq][3]; bi = 3; }
          kh[qq] = bv >= 0.f ? (__float_as_uint(bv) | 0x80000000u) : 0u;
          kl[qq] = 255u - (unsigned)(sb + bi);
        }
#pragma unroll
        for (int off = 32; off > 0; off >>= 1) {
#pragma unroll
          for (int qq = 0; qq < 4; qq++) {
            const unsigned oh = __shfl_xor(kh[qq], off), ol = __shfl_xor(kl[qq], off);
            if (oh > kh[qq] || (oh == kh[qq] && ol > kl[qq])) { kh[qq] = oh; kl[qq] = ol; }
          }
        }
#pragma unroll
        for (int qq = 0; qq < 4; qq++) {
          const int sw = 255 - (int)kl[qq];
          if (kh[qq] != 0u && (sw >> 2) == lane) {
            const int i = sw & 3;
            if (i == 0) vq[qq][0] = -1.f; else if (i == 1) vq[qq][1] = -1.f; else if (i == 2) vq[qq][2] = -1.f; else vq[qq][3] = -1.f;
            nib[qq] |= 1u << i;
          }
        }
      }
    }
#pragma unroll
    for (int qq = 0; qq < 4; qq++) {
      unsigned w = nib[qq] << ((lane & 7) * 4);
      w |= __shfl_xor(w, 1); w |= __shfl_xor(w, 2); w |= __shfl_xor(w, 4);
      const int wi = lane >> 3;
      if (wi == 0) w |= 1u;
      if ((cur >> 5) == wi) w |= 1u << (cur & 31);
      if (cur >= 1 && ((cur - 1) >> 5) == wi) w |= 1u << ((cur - 1) & 31);
      if ((lane & 7) == 0) selw[qq * 8 + wi] = w;
    }
  }
  wave_lds_sync();
  f32x4 outv[4];
  {
    const float gc = NG[t * 32 + H] / fmaxf(sc.l, 1e-30f);
#pragma unroll
    for (int dt = 0; dt < 4; dt++) outv[dt] = sc.o[dt] * gc;
  }
  {
    AttnSt ss; attn_init(ss);
    const bf16_t* Kb = PR0 + C_KS + g * 64;
    const bf16_t* Vb = VST + (size_t)g * 64 * TP;
    for (int wd = 0; wd <= (cur >> 5); wd++) {
      const unsigned myw = selw[ql * 8 + wd];
      unsigned uw = __builtin_amdgcn_readfirstlane(selw[wd] | selw[8 + wd] | selw[16 + wd] | selw[24 + wd]);
      while (uw) {
        const int b = __builtin_ctz(uw);
        uw &= uw - 1u;
        const bool mine = (myw >> b) & 1u;
        attn_block_lds(Kb, LD0, Vb, TP, (wd * 32 + b) * 64, q0, q1, ss, [&](int key) { return mine && key <= t; }, stage, lane);
      }
    }
    attn_finish(ss);
    const float gs = NG[t * 32 + 8 + H] / fmaxf(ss.l, 1e-30f);
#pragma unroll
    for (int dt = 0; dt < 4; dt++) outv[dt] += ss.o[dt] * gs;
  }
  {
    AttnSt sw_; attn_init(sw_);
    const bf16_t* Kb = PR0 + C_KW + g * 64;
    const bf16_t* Vb = VWT + (size_t)g * 64 * TP;
    int start = t0 - 511; if (start < 0) start = 0;
    start &= ~63;
    for (int key0 = start; key0 <= t0 + 3; key0 += 64)
      attn_block_lds(Kb, LD0, Vb, TP, key0, q0, q1, sw_, [&](int key) { return key <= t && key > t - 512; }, stage, lane);
    attn_finish(sw_);
    const float gw = NG[t * 32 + 16 + H] / fmaxf(sw_.l, 1e-30f);
#pragma unroll
    for (int dt = 0; dt < 4; dt++) outv[dt] += sw_.o[dt] * gw;
  }
#pragma unroll
  for (int dt = 0; dt < 4; dt++) {
    const int d = dt * 16 + quad * 4;
    uint2 zv = *(const uint2*)(PR0 + (size_t)t * LD0 + C_NZ + H * 64 + d);
    const f32x4 a = outv[dt];
    uint2 r;
    r.x = pack2(a[0] * bflo(zv.x), a[1] * bfhi(zv.x));
    r.y = pack2(a[2] * bflo(zv.y), a[3] * bfhi(zv.y));
    *(uint2*)(CAT0 + (size_t)t * 1280 + H * 64 + d) = r;
  }
}

#define XB_TMO      128
#define XB_XCNT(j)  (256  + 64 * (j))
#define XB_XSUB(j)  (1280 + 64 * (j))
#define XB_XGEN(j)  (2304 + 64 * (j))
#define XB_TOP      3328
#define XB_TOPGEN   3392
#define XCD_BAR_WORDS 3456
#define XB_SPIN_CAP (1u << 18)
DI unsigned xb_ld(unsigned* p) { return __hip_atomic_load(p, __ATOMIC_RELAXED, __HIP_MEMORY_SCOPE_AGENT); }
DI unsigned xb_add(unsigned* p, unsigned v) { return __hip_atomic_fetch_add(p, v, __ATOMIC_RELAXED, __HIP_MEMORY_SCOPE_AGENT); }
DI unsigned xb_xcc_id() { return (unsigned)__builtin_amdgcn_s_getreg((3 << 11) | 20) & 0xFu; }
#define XB_SPIN(cond, bar) do { unsigned _sp = 0; while (cond) { __builtin_amdgcn_s_sleep(1); \
    if ((++_sp & 255u) == 0u) { if (xb_ld(&(bar)[XB_TMO])) break; if (_sp > XB_SPIN_CAP) { atomicAdd(&(bar)[XB_TMO], 1u); break; } } } } while (0)
struct XcdBarrier { unsigned* bar; unsigned x; unsigned nloc, nx; };
DI void xcd_barrier_complete(unsigned* bar, unsigned x, unsigned& nloc, unsigned& nx) {
  const unsigned G = gridDim.x * gridDim.y * gridDim.z;
  unsigned sum, cnt, mine, sp = 0u;
  for (;;) {
    sum = 0u; cnt = 0u; mine = 0u;
#pragma unroll
    for (unsigned j = 0; j < 16; ++j) { const unsigned c = xb_ld(&bar[XB_XCNT(j)]); sum += c; cnt += (c > 0u) ? 1u : 0u; mine = (j == x) ? c : mine; }
    if (sum == G) break;
    __builtin_amdgcn_s_sleep(1);
    if ((++sp & 255u) == 0u) { if (xb_ld(&bar[XB_TMO])) break; if (sp > XB_SPIN_CAP) { atomicAdd(&bar[XB_TMO], 1u); break; } }
  }
  nloc = mine > 0u ? mine : 1u; nx = cnt > 0u ? cnt : 1u;
}
DI void xcd_barrier(XcdBarrier& b) {
  asm volatile("s_waitcnt vmcnt(0)" ::: "memory");
  __syncthreads();
  if (threadIdx.x == 0) {
    unsigned* bar = b.bar;
    __builtin_amdgcn_s_waitcnt(0);
    if (b.nloc == 0u) xcd_barrier_complete(bar, b.x, b.nloc, b.nx);
    const unsigned nloc = b.nloc, nx = b.nx;
    const unsigned old = xb_add(&bar[XB_XSUB(b.x)], 1u);
    const unsigned gen = old / nloc;
    if (old + 1u == (gen + 1u) * nloc) {
      __builtin_amdgcn_fence(__ATOMIC_RELEASE, "agent");
      asm volatile("s_waitcnt vmcnt(0)" ::: "memory");
      const unsigned og = xb_add(&bar[XB_TOP], 1u);
      const unsigned tg = og / nx;
      if (og + 1u == (tg + 1u) * nx) xb_add(&bar[XB_TOPGEN], 1u);
      else XB_SPIN(xb_ld(&bar[XB_TOPGEN]) == tg, bar);
      __builtin_amdgcn_fence(__ATOMIC_ACQUIRE, "agent");
      xb_add(&bar[XB_XGEN(b.x)], 1u);
      asm volatile("s_waitcnt vmcnt(0)" ::: "memory");
    } else {
      XB_SPIN(xb_ld(&bar[XB_XGEN(b.x)]) == gen, bar);
      __builtin_amdgcn_fence(__ATOMIC_ACQUIRE, "agent");
      asm volatile("s_waitcnt vmcnt(0)" ::: "memory");
    }
  }
  __syncthreads();
}

#define PHASE_IDS                                                                                         \
  int tid_ = threadIdx.x;                                                                                 \
  asm volatile("" : "+v"(tid_));                                                                          \
  const int tid = tid_, lane = tid & 63, wave = tid >> 6, r16 = lane & 15, quad = lane >> 4, wm = wave >> 1, \
            wn = wave & 1, gw = bid * 4 + wave, gtid = bid * 256 + tid;                                   \
  (void)wm; (void)wn; (void)gw; (void)gtid; (void)r16; (void)quad; (void)lane; (void)tid;

DI void raster8(int sq, int TNN, int& tm_l, int& tn) {
  const int rg = sq / (8 * TNN), rem = sq % (8 * TNN);
  const int full = TNN >> 3;
  const int g = rem >> 6;
  if (g < full) { const int w = rem & 63; tm_l = rg * 8 + (w >> 3); tn = g * 8 + (w & 7); }
  else { const int r2 = rem - full * 64, w = TNN & 7; tm_l = rg * 8 + r2 / w; tn = full * 8 + r2 % w; }
}

__global__ void __launch_bounds__(256, 2) fwd_megakernel(Params p) {
  cg::grid_group grid = cg::this_grid();
  __shared__ __attribute__((aligned(16))) char smem_raw[81920];
  bf16_t* smem = (bf16_t*)smem_raw;
  const int tid = threadIdx.x, lane = tid & 63, wave = tid >> 6;
  const int r16 = lane & 15, quad = lane >> 4;
  const int wm = wave >> 1, wn = wave & 1;
  const int bid = blockIdx.x, nb = gridDim.x;
  const int gw = bid * 4 + wave, nw = nb * 4;
  const int gtid = bid * 256 + tid, nthr = nb * 256;
  char* ws = p.ws;
  bf16_t* Y0 = (bf16_t*)(ws + OFF_Y0);
  float* RSTD0 = (float*)(ws + OFF_RSTD0);
  float* RSTD1 = (float*)(ws + OFF_RSTD1);
  bf16_t* MEMN = (bf16_t*)(ws + OFF_MEMN);
  bf16_t* MEMK0 = (bf16_t*)(ws + OFF_MEMK0);
  bf16_t* MEMVT0 = (bf16_t*)(ws + OFF_MEMVT0);
  bf16_t* MEMK1 = (bf16_t*)(ws + OFF_MEMK1);
  bf16_t* MEMVT1 = (bf16_t*)(ws + OFF_MEMVT1);
  bf16_t* WMEM0T = (bf16_t*)(ws + OFF_WMEM0T);
  bf16_t* WMEM1T = (bf16_t*)(ws + OFF_WMEM1T);
  bf16_t* dO = (bf16_t*)p.out;
  unsigned long long* TS = (unsigned long long*)(ws + 33 * Mi + 262144);
  TSTAMP(0);
  XcdBarrier xb; xb.bar = (unsigned*)(ws + OFF_XBAR); xb.x = xb_xcc_id(); xb.nloc = 0u; xb.nx = 0u;
  if (threadIdx.x == 0) (void)xb_add(&xb.bar[XB_XCNT(xb.x)], 1u);

  {
    PHASE_IDS
    for (int t = gw; t < 256; t += nw) {
      const float4* xp = (const float4*)(p.mem + (size_t)t * 1024);
      float4 v[4]; float s = 0.f;
#pragma unroll
      for (int i = 0; i < 4; i++) { v[i] = xp[lane + i * 64]; s += v[i].x * v[i].x + v[i].y * v[i].y + v[i].z * v[i].z + v[i].w * v[i].w; }
#pragma unroll
      for (int o = 32; o > 0; o >>= 1) s += __shfl_xor(s, o);
      const float rs = rsqrtf(s * (1.f / 1024.f) + 1e-6f);
#pragma unroll
      for (int i = 0; i < 4; i++) {
        float4 gg = ((const float4*)p.mem_g)[lane + i * 64];
        uint2 r; r.x = pack2(v[i].x * rs * gg.x, v[i].y * rs * gg.y); r.y = pack2(v[i].z * rs * gg.z, v[i].w * rs * gg.w);
        *(uint2*)(MEMN + (size_t)t * 1024 + (lane + i * 64) * 4) = r;
      }
    }
    transpose_w(p.l0_wmem, 1024, 512, WMEM0T, 512, [](int n) { return n; }, (float*)smem_raw, bid, nb);
    transpose_w(p.l1_wmem, 1024, 512, WMEM1T, 512, [](int n) { return n; }, (float*)smem_raw, bid, nb);
#if DO_L0
    row_rstd(p.x, nullptr, RSTD0, (bf16_t*)(ws + OFF_XB0), T, gw, nw, lane);
    if (gtid < 512) ((int*)(ws + OFF_CNT))[gtid] = 0;
    transpose_w(p.l0_win, 1024, 4376, (bf16_t*)(ws + OFF_WT0), 4480,
                [](int n) { return n < 1280 ? n : (n < 4352 ? n + 24 : (n < 4376 ? n - 4352 + 1280 : -1)); },
                (float*)smem_raw, bid, nb, p.l0_g);
    transpose_w(p.l0_wout, 1280, 1024, (bf16_t*)(ws + OFF_WOUT0T), 1024, [](int n) { return n; }, (float*)smem_raw, bid, nb);
    transpose_w(p.w1_k, 2048, 64, (bf16_t*)(ws + OFF_W1KT), 64, [](int n) { return n; }, (float*)smem_raw, bid, nb);
    transpose_w(p.w1_v, 2048, 64, (bf16_t*)(ws + OFF_W1VT), 64, [](int n) { return n; }, (float*)smem_raw, bid, nb);
    transpose_w(p.w2_k, 64, 64, (bf16_t*)(ws + OFF_W2KT), 64, [](int n) { return n; }, (float*)smem_raw, bid, nb);
    transpose_w(p.w2_v, 64, 64, (bf16_t*)(ws + OFF_W2VT), 64, [](int n) { return n; }, (float*)smem_raw, bid, nb);
    {
      float* RC = (float*)(ws + OFF_ROPE0C); float* RS = (float*)(ws + OFF_ROPE0S);
      for (int i = gtid; i < T * 32; i += nthr) {
        const int t = i >> 5, d = i & 31;
        const double inv = exp2(-(double)d / 32.0 * 13.287712379549449);
        const double rev = (double)p.pos[t] * inv * 0.15915494309189535;
        const float fr = (float)(rev - floor(rev));
        RC[i] = __builtin_amdgcn_cosf(fr); RS[i] = __builtin_amdgcn_sinf(fr);
      }
    }
#endif
  }
  if (gridDim.x == 0x7fffffffu) grid.sync();
  xcd_barrier(xb);
  TSTAMP(1);

#if DO_L0
  {
    PHASE_IDS
    const bf16_t* WT0 = (const bf16_t*)(ws + OFF_WT0);
    bf16_t* PR0 = (bf16_t*)(ws + OFF_PR0);
    const float* RC = (const float*)(ws + OFF_ROPE0C); const float* RS = (const float*)(ws + OFF_ROPE0S);
    float* NG = (float*)(ws + OFF_NG);
    const bf16_t* XB0 = (const bf16_t*)(ws + OFF_XB0);
    for (int it = bid; it < 16; it += nb) {
        const int j = it, layer = j >> 3, tm = (j >> 2) & 1, tn = j & 3;
        const bf16_t* Wt = layer ? WMEM1T : WMEM0T;
        bf16_t* MK = layer ? MEMK1 : MEMK0; bf16_t* MV = layer ? MEMVT1 : MEMVT0;
        const int m0 = tm * 128, n0 = tn * 128;
        auto la = [&](int kt, int row, int ch) { return ld_bf(MEMN, 1024, m0 + row, kt, ch); };
        auto lb = [&](int kt, int row, int ch) { return ld_bf(Wt, 1024, n0 + row, kt, ch); };
        f32x4 acc[4][4]; zero_acc(acc);
        if (n0 < 256) {
          gemm_tile<4, 4, true>(acc, 16, la, lb, smem);
#pragma unroll
          for (int i = 0; i < 4; i++)
#pragma unroll
            for (int jj = 0; jj < 4; jj++) {
              const int m = m0 + wm * 64 + i * 16 + r16, n = n0 + wn * 64 + jj * 16 + quad * 4;
              *(uint2*)(MK + (size_t)m * 256 + n) = pack4(acc[i][jj]);
            }
        } else {
          gemm_tile<4, 4, false>(acc, 16, la, lb, smem);
#pragma unroll
          for (int i = 0; i < 4; i++)
#pragma unroll
            for (int jj = 0; jj < 4; jj++) {
              const int m = m0 + wm * 64 + i * 16 + quad * 4, n = n0 + wn * 64 + jj * 16 + r16 - 256;
              *(uint2*)(MV + (size_t)n * 256 + m) = pack4(acc[i][jj]);
            }
        }
    }
    const int xcd = bid & 7, lid = bid >> 3, nl = nb >> 3;
    for (int sq = lid; sq < 16 * 35; sq += nl) {
      int tml, tn; raster8(sq, 35, tml, tn);
      const int tm = xcd * 16 + tml;
      const int m0 = tm * 128, n0 = tn * 128;
      auto la = [&](int kt, int row, int ch) { return ld_bf(XB0, 1024, m0 + row, kt, ch); };
      auto lb = [&](int kt, int row, int ch) { return ld_bf(WT0, 1024, n0 + row, kt, ch); };
      f32x4 acc[4][4]; zero_acc(acc);
      const bool isT = (n0 == C_VS) || (n0 == C_VW) || (n0 >= C_MV && n0 < C_MZ);
      if (isT) {
        gemm_tile<4, 4, false>(acc, 16, la, lb, smem);
        bf16_t* dst; int nbase;
        if (n0 == C_VS) { dst = (bf16_t*)(ws + OFF_VST); nbase = C_VS; }
        else if (n0 == C_VW) { dst = (bf16_t*)(ws + OFF_VWT); nbase = C_VW; }
        else { dst = (bf16_t*)(ws + OFF_MVT); nbase = C_MV; }
#pragma unroll
        for (int i = 0; i < 4; i++)
#pragma unroll
          for (int jj = 0; jj < 4; jj++) {
            const int m = m0 + wm * 64 + i * 16 + quad * 4, n = n0 + wn * 64 + jj * 16 + r16 - nbase;
            const f32x4 rs4 = *(const f32x4*)(RSTD0 + m);
            *(uint2*)(dst + (size_t)n * TP + m) = pack4(acc[i][jj] * rs4);
          }
      } else {
        gemm_tile<4, 4, true>(acc, 16, la, lb, smem);
        const int nbw = n0 + wn * 64;
        const bool rope = (nbw < 640) || (nbw >= C_KS && nbw < C_VS) || (nbw >= C_KW && nbw < C_VW) || (nbw >= C_MQ && nbw < C_MV);
        const bool qs = (nbw < 512) || (nbw >= C_MQ && nbw < C_MK) || (nbw >= C_EQ && nbw < C_EZ);
        const bool sl = (nbw >= C_NZ && nbw < C_MQ) || (nbw >= C_MZ && nbw < C_EQ) || (nbw >= C_EZ && nbw < C_NG);
#pragma unroll
        for (int i = 0; i < 4; i++) {
          const int t = m0 + wm * 64 + i * 16 + r16;
          {
            const float rs = RSTD0[t];
#pragma unroll
            for (int jj = 0; jj < 4; jj++) acc[i][jj] *= rs;
          }
          if (n0 == C_NG) {
            if (wn == 0) {
#pragma unroll
              for (int jj = 0; jj < 2; jj++)
#pragma unroll
                for (int r = 0; r < 4; r++) {
                  const int idx = jj * 16 + quad * 4 + r;
                  if (idx < 24) NG[t * 32 + idx] = sigm_f(acc[i][jj][r] + p.l0_gb[idx]);
                }
            }
            continue;
          }
          if (rope) {
#pragma unroll
            for (int jj = 0; jj < 2; jj++) {
              const int d0 = jj * 16 + quad * 4;
              const f32x4 cc = *(const f32x4*)(RC + t * 32 + d0);
              const f32x4 ssn = *(const f32x4*)(RS + t * 32 + d0);
              f32x4 x1 = acc[i][jj], x2 = acc[i][jj + 2];
#pragma unroll
              for (int r = 0; r < 4; r++) {
                acc[i][jj][r] = x1[r] * cc[r] - x2[r] * ssn[r];
                acc[i][jj + 2][r] = x1[r] * ssn[r] + x2[r] * cc[r];
              }
            }
          }
#pragma unroll
          for (int jj = 0; jj < 4; jj++) {
            f32x4 v = acc[i][jj];
            if (qs) { v[0] *= QSCALE; v[1] *= QSCALE; v[2] *= QSCALE; v[3] *= QSCALE; }
            if (sl) { v[0] = silu_f(v[0]); v[1] = silu_f(v[1]); v[2] = silu_f(v[2]); v[3] = silu_f(v[3]); }
            *(uint2*)(PR0 + (size_t)t * LD0 + nbw + jj * 16 + quad * 4) = pack4(v);
          }
        }
      }
    }
  }
  xcd_barrier(xb);
  TSTAMP(2);

  {
    PHASE_IDS
    const bf16_t* PR0 = (const bf16_t*)(ws + OFF_PR0);
    bf16_t* KMEAN = (bf16_t*)(ws + OFF_KMEAN);
    bf16_t* HID = (bf16_t*)(ws + OFF_HID);
    for (int it = bid; it < 64 + 512; it += nb) {
      if (it >= 64) {
        const int j = it - 64, n = j >> 3, hd_ = (j & 7) * 64 + (tid & 63), part = tid >> 6;
        float s = 0.f;
#pragma unroll 8
        for (int r = 0; r < 64; r++) s += bf2f(PR0[(size_t)(n * 256 + part * 64 + r) * LD0 + C_MK + hd_]);
        float* red = (float*)smem_raw;
        red[tid] = s;
        __syncthreads();
        if (part == 0) KMEAN[n * 512 + hd_] = f2bf((red[tid] + red[tid + 64] + red[tid + 128] + red[tid + 192]) * (1.f / 256.f));
        __syncthreads();
        continue;
      }
      const int var = it >> 4, mt = it & 15;
      const int isv = var >> 1, g = var & 1;
      const int m0 = mt * 64;
      const int coff = (isv ? C_VCI : C_KCI) + g * 64;
      const bf16_t* W1T = (const bf16_t*)(ws + (isv ? OFF_W1VT : OFF_W1KT));
      const bf16_t* W2T = (const bf16_t*)(ws + (isv ? OFF_W2VT : OFF_W2KT));
      const float* pe = isv ? p.pe_v : p.pe_k;
      auto la = [&](int kt, int row, int ch) -> uint4 {
        const int n = m0 + row;
        if (n > 1022) return make_uint4(0, 0, 0, 0);
        const uint4 av = *(const uint4*)(PR0 + (size_t)(16 * n + kt) * LD0 + coff + ch * 8);
        const float4 p0 = *(const float4*)(pe + kt * 64 + ch * 8), p1 = *(const float4*)(pe + kt * 64 + ch * 8 + 4);
        uint4 r;
        r.x = pack2(bflo(av.x) + p0.x, bfhi(av.x) + p0.y); r.y = pack2(bflo(av.y) + p0.z, bfhi(av.y) + p0.w);
        r.z = pack2(bflo(av.z) + p1.x, bfhi(av.z) + p1.y); r.w = pack2(bflo(av.w) + p1.z, bfhi(av.w) + p1.w);
        return r;
      };
      auto lb = [&](int kt, int row, int ch) { return ld_bf(W1T, 2048, row, kt, ch); };
      f32x4 acc[2][2]; zero_acc(acc);
      gemm_tile<2, 2, true>(acc, 32, la, lb, smem);
      bf16_t* hid = HID + (size_t)var * 1024 * 64;
#pragma unroll
      for (int i = 0; i < 2; i++)
#pragma unroll
        for (int jj = 0; jj < 2; jj++) {
          const int m = m0 + wm * 32 + i * 16 + r16, n = wn * 32 + jj * 16 + quad * 4;
          f32x4 v = acc[i][jj];
#pragma unroll
          for (int r = 0; r < 4; r++) v[r] = silu_f(v[r]);
          *(uint2*)(hid + (size_t)m * 64 + n) = pack4(v);
        }
      __threadfence_block();
      __syncthreads();
      auto la2 = [&](int kt, int row, int ch) { return ld_bf(hid, 64, m0 + row, kt, ch); };
      auto lb2 = [&](int kt, int row, int ch) { return ld_bf(W2T, 64, row, kt, ch); };
      f32x4 acc2[2][2]; zero_acc(acc2);
      if (!isv) {
        gemm_tile<2, 2, true>(acc2, 1, la2, lb2, smem);
        bf16_t* KC = (bf16_t*)(ws + OFF_KC);
#pragma unroll
        for (int i = 0; i < 2; i++)
#pragma unroll
          for (int jj = 0; jj < 2; jj++) {
            const int m = m0 + wm * 32 + i * 16 + r16, n = wn * 32 + jj * 16 + quad * 4;
            *(uint2*)(KC + (size_t)m * 128 + g * 64 + n) = pack4(acc2[i][jj]);
          }
      } else {
        gemm_tile<2, 2, false>(acc2, 1, la2, lb2, smem);
        bf16_t* VCT = (bf16_t*)(ws + OFF_VCT);
#pragma unroll
        for (int i = 0; i < 2; i++)
#pragma unroll
          for (int jj = 0; jj < 2; jj++) {
            const int m = m0 + wm * 32 + i * 16 + quad * 4, n = wn * 32 + jj * 16 + r16;
            *(uint2*)(VCT + (size_t)(g * 64 + n) * 1024 + m) = pack4(acc2[i][jj]);
          }
      }
    }
  }
  xcd_barrier(xb);
  TSTAMP(3);

  {
    PHASE_IDS
    const bf16_t* PR0 = (const bf16_t*)(ws + OFF_PR0);
    float* impw = (float*)(smem_raw + wave * 18432);
    unsigned* selw = (unsigned*)(smem_raw + 73728) + wave * 32;
    const int N_NSA = 4096 * 2, N_MOBA = 1024 * 8, N_MEM = 1024 * 4;
    for (int it = gw; it < N_NSA + N_MOBA + N_MEM; it += nw) {
      if (it < N_NSA) {
        const int qt = it >> 1, g = it & 1;
        nsa_item(PR0, (const bf16_t*)(ws + OFF_KC), (const bf16_t*)(ws + OFF_VCT), (const bf16_t*)(ws + OFF_VST),
                 (const bf16_t*)(ws + OFF_VWT), (const float*)(ws + OFF_NG), dO, qt * 4, g, impw, selw, lane);
      } else if (it < N_NSA + N_MOBA) {
        const int j = it - N_NSA;
        moba_item(PR0, (const bf16_t*)(ws + OFF_MVT), (const bf16_t*)(ws + OFF_KMEAN), dO, (int*)(ws + OFF_CNT),
                  (int*)((char*)p.out + DOFF_BUCKET), (float*)(ws + OFF_LSESEL), (float*)(ws + OFF_LSEOWN), (j >> 3) * 16, j & 7, lane, (char*)impw);
      } else {
        const int j = it - N_NSA - N_MOBA;
        mem_attn_item(PR0 + C_EQ, LD0, PR0 + C_EZ, LD0, dO + 1024, 1280, MEMK0, MEMVT0, (j >> 2) * 16, j & 3, lane, (char*)impw);
      }
    }
  }
  xcd_barrier(xb);
  TSTAMP(4);

  {
    PHASE_IDS
    const bf16_t* PR0 = (const bf16_t*)(ws + OFF_PR0);
    const int* CNT = (const int*)(ws + OFF_CNT);
    unsigned tcl = 0, tch = 0;
    int lsum = 0;
#pragma unroll
    for (int i = 0; i < 8; i++) {
      const int c = (CNT[lane * 8 + i] + 63) >> 6;
      lsum += c;
      if (i < 4) tcl |= (unsigned)c << (8 * i); else tch |= (unsigned)c << (8 * (i - 4));
    }
    int incl = lsum;
#pragma unroll
    for (int o = 1; o < 64; o <<= 1) { int v = __shfl_up(incl, o); if (lane >= o) incl += v; }
    const int excl = incl - lsum;
    const int total = __shfl(incl, 63);
    for (int it = gw; it < total; it += nw) {
      const unsigned long long bal = __ballot(excl <= it);
      const int owner = 63 - __builtin_clzll(bal);
      int rem = it - excl, pi = 0, tj = 0;
#pragma unroll
      for (int i = 0; i < 8; i++) {
        const int c = (int)(((i < 4 ? tcl : tch) >> (8 * (i & 3))) & 0xffu);
        if (rem >= 0 && rem < c) { pi = i; tj = rem; rem = -1; }
        else if (rem >= 0) rem -= c;
      }
      const int pair = owner * 8 + __shfl(pi, owner);
      const int tile = __shfl(tj, owner);
      const int count = CNT[pair];
      moba_bucket_item(PR0, (const bf16_t*)(ws + OFF_MVT), (const int*)((char*)p.out + DOFF_BUCKET), ws,
                       (float*)(ws + OFF_LSESEL), pair >> 6, pair & 63, tile * 64, count, lane);
    }
  }
  xcd_barrier(xb);
  {
    PHASE_IDS
    const bf16_t* PR0 = (const bf16_t*)(ws + OFF_PR0);
    const float* LSESEL = (const float*)(ws + OFF_LSESEL);
    const float* LSEOWN = (const float*)(ws + OFF_LSEOWN);
    for (int i = gtid; i < T * 64; i += nthr) {
      const int c8 = i & 7, h = (i >> 3) & 7, t = i >> 6;
      const float lo = LSEOWN[(size_t)t * 8 + h];
      const float l0 = LSESEL[((size_t)t * 8 + h) * 3 + 0], l1 = LSESEL[((size_t)t * 8 + h) * 3 + 1], l2 = LSESEL[((size_t)t * 8 + h) * 3 + 2];
      const float M = fmaxf(fmaxf(lo, l0), fmaxf(l1, l2));
      float wo = ex2(lo - M), w0 = ex2(l0 - M), w1 = ex2(l1 - M), w2 = ex2(l2 - M);
      const float inv = 1.f / (wo + w0 + w1 + w2);
      wo *= inv; w0 *= inv; w1 *= inv; w2 *= inv;
      const bf16_t* part = (const bf16_t*)(ws + (h < 5 ? OFF_PARTA + (size_t)h * PART_HEAD : OFF_PARTB + (size_t)(h - 5) * PART_HEAD)) + (size_t)t * 192 + c8 * 8;
      bf16_t* dst = dO + (size_t)t * 1280 + 512 + h * 64 + c8 * 8;
      const uint4 ov = *(const uint4*)dst;
      const uint4 zv = *(const uint4*)(PR0 + (size_t)t * LD0 + C_MZ + h * 64 + c8 * 8);
      uint4 a0 = make_uint4(0, 0, 0, 0), a1 = a0, a2 = a0;
      if (w0 > 0.f) a0 = *(const uint4*)(part);
      if (w1 > 0.f) a1 = *(const uint4*)(part + 64);
      if (w2 > 0.f) a2 = *(const uint4*)(part + 128);
      const unsigned ou[4] = {ov.x, ov.y, ov.z, ov.w}, zu[4] = {zv.x, zv.y, zv.z, zv.w};
      const unsigned u0[4] = {a0.x, a0.y, a0.z, a0.w}, u1[4] = {a1.x, a1.y, a1.z, a1.w}, u2[4] = {a2.x, a2.y, a2.z, a2.w};
      unsigned ru[4];
#pragma unroll
      for (int j = 0; j < 4; j++) {
        const float lo_ = (wo * bflo(ou[j]) + w0 * bflo(u0[j]) + w1 * bflo(u1[j]) + w2 * bflo(u2[j])) * bflo(zu[j]);
        const float hi_ = (wo * bfhi(ou[j]) + w0 * bfhi(u0[j]) + w1 * bfhi(u1[j]) + w2 * bfhi(u2[j])) * bfhi(zu[j]);
        ru[j] = pack2(lo_, hi_);
      }
      *(uint4*)dst = make_uint4(ru[0], ru[1], ru[2], ru[3]);
    }
  }
  xcd_barrier(xb);
  {
    PHASE_IDS
    const bf16_t* WO = (const bf16_t*)(ws + OFF_WOUT0T);
    const int xcd = bid & 7, lid = bid >> 3, nl = nb >> 3;
    for (int sq = lid; sq < 16 * 8; sq += nl) {
      int tml, tn; raster8(sq, 8, tml, tn);
      const int tm = xcd * 16 + tml;
      const int m0 = tm * 128, n0 = tn * 128;
      auto la = [&](int kt, int row, int ch) { return ld_bf(dO, 1280, m0 + row, kt, ch); };
      auto lb = [&](int kt, int row, int ch) { return ld_bf(WO, 1280, n0 + row, kt, ch); };
      f32x4 acc[4][4]; zero_acc(acc);
      gemm_tile<4, 4, true>(acc, 20, la, lb, smem);
#pragma unroll
      for (int i = 0; i < 4; i++)
#pragma unroll
        for (int jj = 0; jj < 4; jj++) {
          const int m = m0 + wm * 64 + i * 16 + r16, n = n0 + wn * 64 + jj * 16 + quad * 4;
          const f32x4 xv = *(const f32x4*)(p.x + (size_t)m * 1024 + n);
          *(uint2*)(Y0 + (size_t)m * 1024 + n) = pack4(acc[i][jj] + xv);
        }
    }
  }
  xcd_barrier(xb);
  TSTAMP(5);
#else
  {
    for (int i = gtid; i < T * 1024 / 4; i += nthr) { const float4 v = ((const float4*)p.x)[i]; uint2 o; o.x = pack2(v.x, v.y); o.y = pack2(v.z, v.w); ((uint2*)Y0)[i] = o; }
    for (int it = bid; it < 8; it += nb) {
      const int tm = (it >> 2) & 1, tn = it & 3;
      const int m0 = tm * 128, n0 = tn * 128;
      auto la = [&](int kt, int row, int ch) { return ld_bf(MEMN, 1024, m0 + row, kt, ch); };
      auto lb = [&](int kt, int row, int ch) { return ld_bf(WMEM1T, 1024, n0 + row, kt, ch); };
      f32x4 acc[4][4]; zero_acc(acc);
      if (n0 < 256) {
        gemm_tile<4, 4, true>(acc, 16, la, lb, smem);
#pragma unroll
        for (int i = 0; i < 4; i++)
#pragma unroll
          for (int jj = 0; jj < 4; jj++) {
            const int m = m0 + wm * 64 + i * 16 + r16, n = n0 + wn * 64 + jj * 16 + quad * 4;
            *(uint2*)(MEMK1 + (size_t)m * 256 + n) = pack4(acc[i][jj]);
          }
      } else {
        gemm_tile<4, 4, false>(acc, 16, la, lb, smem);
#pragma unroll
        for (int i = 0; i < 4; i++)
#pragma unroll
          for (int jj = 0; jj < 4; jj++) {
            const int m = m0 + wm * 64 + i * 16 + quad * 4, n = n0 + wn * 64 + jj * 16 + r16 - 256;
            *(uint2*)(MEMVT1 + (size_t)n * 256 + m) = pack4(acc[i][jj]);
          }
      }
    }
  }
  xcd_barrier(xb);
  TSTAMP(5);
#endif

  {
    PHASE_IDS
    for (int t = gw; t < T; t += nw) {
      const uint4 a = *(const uint4*)(Y0 + (size_t)t * 1024 + lane * 8), b = *(const uint4*)(Y0 + (size_t)t * 1024 + 512 + lane * 8);
      const unsigned u[8] = {a.x, a.y, a.z, a.w, b.x, b.y, b.z, b.w};
      float sq = 0.f;
#pragma unroll
      for (int i = 0; i < 8; i++) { const float lo = bflo(u[i]), hi = bfhi(u[i]); sq += lo * lo + hi * hi; }
#pragma unroll
      for (int o = 32; o > 0; o >>= 1) sq += __shfl_xor(sq, o);
      if (lane == 0) RSTD1[t] = rsqrtf(sq * (1.f / 1024.f) + 1e-6f);
    }
    auto perm = [](int x) { const int h = x >> 8, r = x & 255; return h * 256 + ((r >> 5) & 1) * 128 + (r >> 6) * 32 + (r & 31); };
    transpose_w(p.l1_win, 1024, 6656, (bf16_t*)(ws + OFF_WT1), 4608,
                [&](int n) { return n < 1024 ? perm(n) : (n < 2048 ? 1024 + perm(n - 1024) : (n < 4096 ? n : n + 2048)); },
                (float*)smem_raw, bid, nb, p.l1_g);
    transpose_w(p.l1_win, 1024, 6656, (bf16_t*)(ws + OFF_WRZT), 2048, [](int n) { return 4096 + n; }, (float*)smem_raw, bid, nb, p.l1_g);
    transpose_w(p.l1_wout, 2304, 1024, (bf16_t*)(ws + OFF_WOUT1T), 1024, [](int n) { return n; }, (float*)smem_raw, bid, nb);
    float* RC = (float*)(ws + OFF_ROPE1C); float* RS = (float*)(ws + OFF_ROPE1S);
    for (int i = gtid; i < T * 128; i += nthr) {
      const int t = i >> 7, d = i & 127;
      const double inv = exp2(-(double)d / 127.0 * 13.287712379549449);
      const double rev = (double)p.pos[t] * inv * 0.15915494309189535;
      const float fr = (float)(rev - floor(rev));
      RC[i] = __builtin_amdgcn_cosf(fr); RS[i] = __builtin_amdgcn_sinf(fr);
    }
  }
  xcd_barrier(xb);
  TSTAMP(6);

  bf16_t* Q1 = dO;
  bf16_t* P1 = (bf16_t*)((char*)p.out + DOFF_P);
  bf16_t* KP = (bf16_t*)(ws + OFF_KP);
  bf16_t* KPT = (bf16_t*)(ws + OFF_KPT);
  bf16_t* VT = (bf16_t*)(ws + OFF_VT);
  bf16_t* S1 = (bf16_t*)(ws + OFF_S);
  bf16_t* EQ1 = (bf16_t*)(ws + OFF_EQ1);
  bf16_t* EZ1 = (bf16_t*)(ws + OFF_EZ1);
  bf16_t* O1 = (bf16_t*)(ws + OFF_O);
  bf16_t* Z1 = (bf16_t*)(ws + OFF_Z);

  {
    PHASE_IDS
    const bf16_t* WT1 = (const bf16_t*)(ws + OFF_WT1);
    const float* RC = (const float*)(ws + OFF_ROPE1C); const float* RS = (const float*)(ws + OFF_ROPE1S);
    const bf16_t* XB1 = Y0;
    const int xcd = bid & 7, lid = bid >> 3, nl = nb >> 3;
    for (int sq = lid; sq < 16 * 36; sq += nl) {
      int tml, tn; raster8(sq, 36, tml, tn);
      const int tm = xcd * 16 + tml;
      const int m0 = tm * 128, n0 = tn * 128;
      auto la = [&](int kt, int row, int ch) { return ld_bf(XB1, 1024, m0 + row, kt, ch); };
      auto lb = [&](int kt, int row, int ch) { return ld_bf(WT1, 1024, n0 + row, kt, ch); };
      f32x4 acc[4][4]; zero_acc(acc);
      if (n0 >= 2048 && n0 < 4096) {
        gemm_tile<4, 4, false>(acc, 16, la, lb, smem);
#pragma unroll
        for (int i = 0; i < 4; i++)
#pragma unroll
          for (int jj = 0; jj < 4; jj++) {
            const int m = m0 + wm * 64 + i * 16 + quad * 4, n = n0 + wn * 64 + jj * 16 + r16 - 2048;
            const f32x4 rs4 = *(const f32x4*)(RSTD1 + m);
            *(uint2*)(VT + (size_t)n * TP + m) = pack4(acc[i][jj] * rs4);
          }
      } else {
        gemm_tile<4, 4, true>(acc, 16, la, lb, smem);
        const int nbw = n0 + wn * 64;
#pragma unroll
        for (int i = 0; i < 4; i++) {
          const int t = m0 + wm * 64 + i * 16 + r16;
          {
            const float rs = RSTD1[t];
#pragma unroll
            for (int jj = 0; jj < 4; jj++) acc[i][jj] *= rs;
          }
          if (nbw < 2048) {
            const int cgrp = (nbw & 255) >> 6;
#pragma unroll
            for (int jj = 0; jj < 2; jj++) {
              const int d0 = cgrp * 32 + jj * 16 + quad * 4;
              const f32x4 cc = *(const f32x4*)(RC + t * 128 + d0);
              const f32x4 ssn = *(const f32x4*)(RS + t * 128 + d0);
              f32x4 x1 = acc[i][jj], x2 = acc[i][jj + 2];
#pragma unroll
              for (int r = 0; r < 4; r++) {
                acc[i][jj][r] = x1[r] * cc[r] - x2[r] * ssn[r];
                acc[i][jj + 2][r] = x1[r] * ssn[r] + x2[r] * cc[r];
              }
            }
            if (nbw < 1024) {
#pragma unroll
              for (int jj = 0; jj < 4; jj++)
                *(uint2*)(Q1 + (size_t)t * 1024 + nbw + jj * 16 + quad * 4) = pack4(acc[i][jj]);
            } else {
              const int h = (nbw - 1024) >> 8;
              const float lg = log2f(1.f - exp2f(-5.f - (float)h));
              const float ksc = 0.0625f * exp2f(-(float)((t & 255) + 1) * lg);
#pragma unroll
              for (int jj = 0; jj < 4; jj++) {
                f32x4 v = acc[i][jj];
                v[0] *= ksc; v[1] *= ksc; v[2] *= ksc; v[3] *= ksc;
                const int n = nbw - 1024 + jj * 16 + quad * 4;
                *(uint2*)(KP + (size_t)t * 1024 + n) = pack4(v);
#pragma unroll
                for (int r = 0; r < 4; r++) KPT[(size_t)(n + r) * TP + t] = f2bf(v[r]);
              }
            }
          } else if (nbw < 4352) {
#pragma unroll
            for (int jj = 0; jj < 4; jj++) {
              f32x4 v = acc[i][jj];
              v[0] *= QSCALE; v[1] *= QSCALE; v[2] *= QSCALE; v[3] *= QSCALE;
              *(uint2*)(EQ1 + (size_t)t * 256 + nbw - 4096 + jj * 16 + quad * 4) = pack4(v);
            }
          } else {
#pragma unroll
            for (int jj = 0; jj < 4; jj++) {
              f32x4 v = acc[i][jj];
              v[0] = silu_f(v[0]); v[1] = silu_f(v[1]); v[2] = silu_f(v[2]); v[3] = silu_f(v[3]);
              *(uint2*)(EZ1 + (size_t)t * 256 + nbw - 4352 + jj * 16 + quad * 4) = pack4(v);
            }
          }
        }
      }
    }
  }
  xcd_barrier(xb);
  TSTAMP(7);

  {
    PHASE_IDS
    const int xcd7 = bid & 7, lid7 = bid >> 3, nl7 = nb >> 3;
    for (int sq = lid7; sq < 512; sq += nl7) {
      const int it = xcd7 * 512 + sq;
      if (it < 2048) {
        const int h = it >> 9, c = (it >> 3) & 63, tm = (it >> 1) & 3, tn = it & 1;
        const bf16_t* Ab = VT + (size_t)(h * 512 + tm * 128) * TP + c * 256;
        const bf16_t* Bb = KPT + (size_t)(h * 256 + tn * 128) * TP + c * 256;
        auto la = [&](int kt, int row, int ch) { return ld_bf(Ab, TP, row, kt, ch); };
        auto lb = [&](int kt, int row, int ch) { return ld_bf(Bb, TP, row, kt, ch); };
        f32x4 acc[4][4]; zero_acc(acc);
        gemm_tile<4, 4, true>(acc, 4, la, lb, smem);
        bf16_t* Sd = S1 + ((size_t)(h * 64 + c) * 512 + tm * 128) * 256 + tn * 128;
#pragma unroll
        for (int i = 0; i < 4; i++)
#pragma unroll
          for (int jj = 0; jj < 4; jj++) {
            const int m = wm * 64 + i * 16 + r16, n = wn * 64 + jj * 16 + quad * 4;
            *(uint2*)(Sd + (size_t)m * 256 + n) = pack4(acc[i][jj]);
          }
      } else if (it < 3072) {
        const int j = it - 2048;
        const int h = j >> 8, c = (j >> 2) & 63, tm = (j >> 1) & 1, tn = j & 1;
        const int m0 = c * 256 + tm * 128, n0 = c * 256 + tn * 128;
        auto la = [&](int kt, int row, int ch) { return ld_bf(Q1 + h * 256, 1024, m0 + row, kt, ch); };
        auto lb = [&](int kt, int row, int ch) { return ld_bf(KP + h * 256, 1024, n0 + row, kt, ch); };
        f32x4 acc[4][4]; zero_acc(acc);
        if (tn <= tm) gemm_tile<4, 4, true>(acc, 4, la, lb, smem);
#pragma unroll
        for (int i = 0; i < 4; i++)
#pragma unroll
          for (int jj = 0; jj < 4; jj++) {
            const int m = m0 + wm * 64 + i * 16 + r16, n = n0 + wn * 64 + jj * 16 + quad * 4;
            f32x4 v = acc[i][jj];
#pragma unroll
            for (int r = 0; r < 4; r++) if (n + r > m) v[r] = 0.f;
            *(uint2*)(P1 + ((size_t)h * T + m) * 256 + (n - c * 256)) = pack4(v);
          }
      } else {
        const int j = (it - 3072) * 4 + wave;
        mem_attn_item(EQ1, 256, EZ1, 256, EQ1, 256, MEMK1, MEMVT1, (j >> 2) * 16, j & 3, lane, smem_raw + wave * 18432);
      }
    }
  }
  xcd_barrier(xb);
  {
    PHASE_IDS
    for (int e = gtid; e < 4 * 16384; e += nthr) {
      const int h = e >> 14, idx = (e & 16383) * 8;
      const float gL = exp2f(256.f * log2f(1.f - exp2f(-5.f - (float)h)));
      float s0 = 0.f, s1 = 0.f, s2 = 0.f, s3 = 0.f, s4 = 0.f, s5 = 0.f, s6 = 0.f, s7 = 0.f;
      bf16_t* base = S1 + (((size_t)h * 64) << 17) + idx;
      uint4 u = *(const uint4*)base;
      for (int c = 0; c < 64; c++) {
        uint4* pp = (uint4*)(base + ((size_t)c << 17));
        uint4 un = u;
        if (c + 1 < 64) un = *(const uint4*)(base + ((size_t)(c + 1) << 17));
        uint4 o;
        o.x = pack2(s0, s1); o.y = pack2(s2, s3); o.z = pack2(s4, s5); o.w = pack2(s6, s7);
        *pp = o;
        s0 = gL * (s0 + bflo(u.x)); s1 = gL * (s1 + bfhi(u.x));
        s2 = gL * (s2 + bflo(u.y)); s3 = gL * (s3 + bfhi(u.y));
        s4 = gL * (s4 + bflo(u.z)); s5 = gL * (s5 + bfhi(u.z));
        s6 = gL * (s6 + bflo(u.w)); s7 = gL * (s7 + bfhi(u.w));
        u = un;
      }
    }
  }
  xcd_barrier(xb);
  TSTAMP(8);

  {
    PHASE_IDS
    const int xcd8 = bid & 7, lid8 = bid >> 3, nl8 = nb >> 3;
    for (int sq = lid8; sq < 256; sq += nl8) {
      const int it = xcd8 * 256 + sq;
      const int h = it >> 9, c = (it >> 3) & 63, tm = (it >> 2) & 1, tn = it & 3;
      const int m0 = c * 256 + tm * 128, n0 = tn * 128;
      const bf16_t* Sb = S1 + ((size_t)(h * 64 + c) * 512 + n0) * 256;
      const bf16_t* Pb = P1 + ((size_t)h * T + m0) * 256;
      const bf16_t* Vb = VT + (size_t)(h * 512 + n0) * TP + c * 256;
      const bf16_t* Qb = Q1 + (size_t)m0 * 1024 + h * 256;
      auto la = [&](int kt, int row, int ch) {
        const bf16_t* b = kt < 4 ? Qb : Pb; const int ld = kt < 4 ? 1024 : 256;
        return *(const uint4*)(b + (size_t)(row * ld) + (kt & 3) * 64 + ch * 8);
      };
      auto lb = [&](int kt, int row, int ch) {
        const bf16_t* b = kt < 4 ? Sb : Vb; const int ld = kt < 4 ? 256 : TP;
        return *(const uint4*)(b + (size_t)(row * ld) + (kt & 3) * 64 + ch * 8);
      };
      f32x4 acc[4][4]; zero_acc(acc);
      gemm_tile<4, 4, true>(acc, tm == 0 ? 6 : 8, la, lb, smem);
      const float lg = log2f(1.f - exp2f(-5.f - (float)h));
#pragma unroll
      for (int i = 0; i < 4; i++) {
        const int t = m0 + wm * 64 + i * 16 + r16;
        const float qd = exp2f((float)((t & 255) + 1) * lg);
#pragma unroll
        for (int jj = 0; jj < 4; jj++) {
          f32x4 v = acc[i][jj];
          v[0] *= qd; v[1] *= qd; v[2] *= qd; v[3] *= qd;
          *(uint2*)(O1 + (size_t)t * 2048 + h * 512 + n0 + wn * 64 + jj * 16 + quad * 4) = pack4(v);
        }
      }
    }
  }
  xcd_barrier(xb);
  TSTAMP(9);

  {
    PHASE_IDS
    const bf16_t* WRZT = (const bf16_t*)(ws + OFF_WRZT);
    const int xcd = bid & 7, lid = bid >> 3, nl = nb >> 3;
    for (int sq = lid; sq < 16 * 16; sq += nl) {
      int tml, tn; raster8(sq, 16, tml, tn);
      const int tm = xcd * 16 + tml;
      const int m0 = tm * 128, n0 = tn * 128;
      auto la = [&](int kt, int row, int ch) { return ld_bf(Y0, 1024, m0 + row, kt, ch); };
      auto lb = [&](int kt, int row, int ch) { return ld_bf(WRZT, 1024, n0 + row, kt, ch); };
      f32x4 acc[4][4]; zero_acc(acc);
      gemm_tile<4, 4, true>(acc, 16, la, lb, smem);
#pragma unroll
      for (int i = 0; i < 4; i++)
#pragma unroll
        for (int jj = 0; jj < 4; jj++) {
          const int m = m0 + wm * 64 + i * 16 + r16, n = n0 + wn * 64 + jj * 16 + quad * 4;
          f32x4 v = acc[i][jj] * RSTD1[m];
          v[0] = silu_f(v[0]); v[1] = silu_f(v[1]); v[2] = silu_f(v[2]); v[3] = silu_f(v[3]);
          *(uint2*)(Z1 + (size_t)m * 2048 + n) = pack4(v);
        }
    }
  }
  xcd_barrier(xb);
  TSTAMP(10);

  {
    PHASE_IDS
    for (int it = gw; it < T * 4; it += nw) {
      const size_t off = (size_t)it * 512 + lane * 8;
      uint4 ov = *(const uint4*)(O1 + off);
      uint4 zv = *(const uint4*)(Z1 + off);
      float o[8] = {bflo(ov.x), bfhi(ov.x), bflo(ov.y), bfhi(ov.y), bflo(ov.z), bfhi(ov.z), bflo(ov.w), bfhi(ov.w)};
      float z[8] = {bflo(zv.x), bfhi(zv.x), bflo(zv.y), bfhi(zv.y), bflo(zv.z), bfhi(zv.z), bflo(zv.w), bfhi(zv.w)};
      float s = 0.f;
#pragma unroll
      for (int i = 0; i < 8; i++) s += o[i];
#pragma unroll
      for (int k = 32; k > 0; k >>= 1) s += __shfl_xor(s, k);
      const float mu = s * (1.f / 512.f);
      float v = 0.f;
#pragma unroll
      for (int i = 0; i < 8; i++) { o[i] -= mu; v += o[i] * o[i]; }
#pragma unroll
      for (int k = 32; k > 0; k >>= 1) v += __shfl_xor(v, k);
      const float rs = rsqrtf(v * (1.f / 512.f) + 1e-6f);
      uint4 r;
      r.x = pack2(o[0] * rs * z[0], o[1] * rs * z[1]); r.y = pack2(o[2] * rs * z[2], o[3] * rs * z[3]);
      r.z = pack2(o[4] * rs * z[4], o[5] * rs * z[5]); r.w = pack2(o[6] * rs * z[6], o[7] * rs * z[7]);
      *(uint4*)(Z1 + off) = r;
    }
  }
  xcd_barrier(xb);
  TSTAMP(11);

  {
    PHASE_IDS
    const bf16_t* WO = (const bf16_t*)(ws + OFF_WOUT1T);
    const int xcd = bid & 7, lid = bid >> 3, nl = nb >> 3;
    for (int sq = lid; sq < 16 * 8; sq += nl) {
      int tml, tn; raster8(sq, 8, tml, tn);
      const int tm = xcd * 16 + tml;
      const int m0 = tm * 128, n0 = tn * 128;
      auto la = [&](int kt, int row, int ch) {
        return kt < 32 ? ld_bf(Z1, 2048, m0 + row, kt, ch) : ld_bf(EQ1, 256, m0 + row, kt - 32, ch);
      };
      auto lb = [&](int kt, int row, int ch) { return ld_bf(WO, 2304, n0 + row, kt, ch); };
      f32x4 acc[4][4]; zero_acc(acc);
      gemm_tile<4, 4, true>(acc, 36, la, lb, smem);
#pragma unroll
      for (int i = 0; i < 4; i++)
#pragma unroll
        for (int jj = 0; jj < 4; jj++) {
          if (jj == 0) __builtin_amdgcn_sched_barrier(0);
          const int m = m0 + wm * 64 + i * 16 + r16, n = n0 + wn * 64 + jj * 16 + quad * 4;
          const uint2 yv = *(const uint2*)(Y0 + (size_t)m * 1024 + n);
          float4 r;
          r.x = bflo(yv.x) + acc[i][jj][0]; r.y = bfhi(yv.x) + acc[i][jj][1];
          r.z = bflo(yv.y) + acc[i][jj][2]; r.w = bfhi(yv.y) + acc[i][jj][3];
          *(float4*)(p.out + (size_t)m * 1024 + n) = r;
        }
    }
  }
  xcd_barrier(xb);
  TSTAMP(12);

  {
    PHASE_IDS
    for (int t = gw; t < T; t += nw) {
      float4* xp = (float4*)(p.out + (size_t)t * 1024);
      float4 v[4]; float s = 0.f;
#pragma unroll
      for (int i = 0; i < 4; i++) { v[i] = xp[lane + i * 64]; s += v[i].x * v[i].x + v[i].y * v[i].y + v[i].z * v[i].z + v[i].w * v[i].w; }
#pragma unroll
      for (int o = 32; o > 0; o >>= 1) s += __shfl_xor(s, o);
      const float rs = rsqrtf(s * (1.f / 1024.f) + 1e-6f);
#pragma unroll
      for (int i = 0; i < 4; i++) {
        const float4 gg = ((const float4*)p.fin_g)[lane + i * 64];
        v[i].x *= rs * gg.x; v[i].y *= rs * gg.y; v[i].z *= rs * gg.z; v[i].w *= rs * gg.w;
        xp[lane + i * 64] = v[i];
      }
    }
  }
  if (TSA_MASK | TSB_MASK) {
    xcd_barrier(xb);
    TSTAMP(13);
    if (blockIdx.x == 0) {
      float a = 0.f, b = 0.f;
      for (int k = 0; k < 13; k++) {
        float d = (float)(TS[k + 1] - TS[k]) * 0.00001f;
        if ((TSA_MASK >> k) & 1) a += d;
        if ((TSB_MASK >> k) & 1) b += d;
      }
      if (threadIdx.x == 0) p.out[0] += a;
      for (int i = threadIdx.x; i < 1048576; i += 256) p.out[1024 + i] += 0.1f * b;
    }
  }
}

extern "C" void kernel_launch(void* const* d_in, const int* in_sizes, int n_in,
                              void* d_out, int out_size, void* d_ws, size_t ws_size,
                              hipStream_t stream) {
  static int grid_blocks = 0;
  if (!grid_blocks) {
    int dev = 0, cus = 0, per_cu = 0;
    (void)hipGetDevice(&dev);
    (void)hipDeviceGetAttribute(&cus, hipDeviceAttributeMultiprocessorCount, dev);
    (void)hipOccupancyMaxActiveBlocksPerMultiprocessor(&per_cu, fwd_megakernel, 256, 0);
    if (per_cu < 1) per_cu = 1;
    if (per_cu > 2) per_cu = 2;
    grid_blocks = cus * per_cu;
  }
  Params p{};
  p.x = (const float*)d_in[0]; p.mem = (const float*)d_in[1]; p.pos = (const int*)d_in[2];
  p.l0_g = (const float*)d_in[3]; p.l0_win = (const float*)d_in[4]; p.l0_gb = (const float*)d_in[5];
  p.pe_k = (const float*)d_in[6]; p.w1_k = (const float*)d_in[7]; p.w2_k = (const float*)d_in[8];
  p.pe_v = (const float*)d_in[9]; p.w1_v = (const float*)d_in[10]; p.w2_v = (const float*)d_in[11];
  p.l0_wmem = (const float*)d_in[12]; p.l0_wout = (const float*)d_in[13];
  p.l1_g = (const float*)d_in[14]; p.l1_win = (const float*)d_in[15]; p.l1_wmem = (const float*)d_in[16];
  p.l1_wout = (const float*)d_in[17]; p.mem_g = (const float*)d_in[18]; p.fin_g = (const float*)d_in[19];
  p.out = (float*)d_out; p.ws = (char*)d_ws;
  (void)hipMemsetAsync((char*)d_ws + OFF_XBAR, 0, XCD_BAR_WORDS * 4, stream);
  void* args[] = {&p};
  hipError_t e = hipLaunchCooperativeKernel((void*)fwd_megakernel, dim3(grid_blocks), dim3(256), args, 0, stream);
  if (e != hipSuccess) fprintf(stderr, "cooperative launch failed: %s (grid %d)\n", hipGetErrorString(e), grid_blocks);
}
```
